# Optimizing an MI355X kernel written in HIP

```python
import jax, jax.numpy as jnp
from jax import lax
import numpy as np

D_MODEL = 1024
BATCH = 2
SEQ = 8192
DEPTH = 4

GRID_W = 64
CTX_LEN = 256
HEAD_DIM = 64
HALF_ROT = HEAD_DIM // 2
AXIS_FREQS = HEAD_DIM // 4
ROPE_THETA = 10000.0
RW_HEADS = 6
RW_DIM = RW_HEADS * HEAD_DIM
RW_LORA_W = 64
RW_LORA_A = 64
AT_HEADS = 6
AT_KV_HEADS = 2
AT_GROUP = AT_HEADS // AT_KV_HEADS
AT_DIM = AT_HEADS * HEAD_DIM
AT_KV_DIM = AT_KV_HEADS * HEAD_DIM
WINDOW = 128
BLOCK = 128
CV_GROUPS = 4
CV_DIM = CV_GROUPS * HEAD_DIM
CONV_W = 3
D_MIX = RW_DIM + AT_DIM + CV_DIM
IN_SPLITS = (RW_DIM, RW_DIM, RW_DIM, RW_DIM, 2 * RW_LORA_W, 2 * RW_LORA_A,
             AT_DIM, AT_KV_DIM, AT_KV_DIM, AT_DIM,
             CV_DIM, CV_DIM, CV_DIM, CV_DIM)
D_IN = 4 * RW_DIM + 2 * RW_LORA_W + 2 * RW_LORA_A + 2 * AT_DIM + 2 * AT_KV_DIM + 4 * CV_DIM
NORM_EPS = 1e-6
LNX_EPS = 64e-5
MASK_VALUE = -1e30

kernel_name = "hybrid_rwkv7_swa_shortconv_dit"


def rmsnorm(x, g):
    xf = x.astype(jnp.float32)
    y = xf * lax.rsqrt(jnp.mean(xf * xf, axis=-1, keepdims=True) + NORM_EPS)
    return (y * g.astype(jnp.float32)).astype(x.dtype)


def to_heads(t):
    return t.reshape(t.shape[:-1] + (-1, HEAD_DIM))


def axial_rope_tables(row, col):
    inv = ROPE_THETA ** (-jnp.arange(AXIS_FREQS, dtype=jnp.float32) / AXIS_FREQS)
    ang = jnp.concatenate([row.astype(jnp.float32)[:, None] * inv,
                           col.astype(jnp.float32)[:, None] * inv], axis=-1)
    return jnp.cos(ang), jnp.sin(ang)


def apply_rope(t, cos, sin):
    tf = t.astype(jnp.float32)
    t1, t2 = tf[..., :HALF_ROT], tf[..., HALF_ROT:]
    c, s = cos[:, None, :], sin[:, None, :]
    return jnp.concatenate([t1 * c - t2 * s, t1 * s + t2 * c], axis=-1).astype(t.dtype)


def rwkv7_scan(r, w, k, v, kk, a, s0, reverse):
    def step(S, inp):
        r_t, w_t, k_t, v_t, kk_t, a_t = inp
        sa = jnp.einsum("bhvk,bhk->bhv", S, kk_t)
        S = (S * w_t[:, :, None, :] - sa[..., None] * (kk_t * a_t)[:, :, None, :]
             + v_t[..., None] * k_t[:, :, None, :])
        return S, jnp.einsum("bhvk,bhk->bhv", S, r_t)
    xs = tuple(jnp.moveaxis(t.astype(jnp.float32), 1, 0) for t in (r, w, k, v, kk, a))
    s_final, ys = lax.scan(step, s0, xs, reverse=reverse)
    return jnp.moveaxis(ys, 0, 1), s_final


def rwkv7_branch(parts, w0, w_up, a0, a_up, k_k, k_a, r_k, ln_g, ln_b, s0):
    r, k, v, g, wd, ad = parts
    r, k, v = to_heads(r), to_heads(k), to_heads(v)
    kk = (k * k_k.reshape(RW_HEADS, HEAD_DIM)).astype(jnp.float32)
    kk = kk * lax.rsqrt(jnp.maximum(jnp.sum(kk * kk, axis=-1, keepdims=True), 1e-12))
    ys, states = [], []
    for d in range(2):
        lw = (w0[d] + jnp.tanh(wd[..., d * RW_LORA_W:(d + 1) * RW_LORA_W]) @ w_up[d]).astype(jnp.float32)
        decay = jnp.exp(-jnp.exp(-jax.nn.softplus(-lw) - 0.5))
        a = to_heads(jax.nn.sigmoid(a0[d] + ad[..., d * RW_LORA_A:(d + 1) * RW_LORA_A] @ a_up[d]))
        k_d = k * (1 + (a - 1) * k_a.reshape(RW_HEADS, HEAD_DIM))
        y_d, s_d = rwkv7_scan(r, to_heads(decay), k_d, v, kk, a, s0[d], reverse=(d == 1))
        ys.append(y_d)
        states.append(s_d)
    y = ys[0] + ys[1]
    mu = jnp.mean(y, axis=-1, keepdims=True)
    var = jnp.mean(jnp.square(y - mu), axis=-1, keepdims=True)
    y = ((y - mu) * lax.rsqrt(var + LNX_EPS) * ln_g.reshape(RW_HEADS, HEAD_DIM).astype(jnp.float32)
         + ln_b.reshape(RW_HEADS, HEAD_DIM).astype(jnp.float32))
    bonus = jnp.sum((r * k * r_k).astype(jnp.float32), axis=-1, keepdims=True) * v.astype(jnp.float32)
    y = (y + bonus).reshape(y.shape[:2] + (RW_DIM,)).astype(g.dtype) * jax.nn.silu(g)
    return y, (states[0], states[1])


def sink_softmax(logits, sink):
    s = jnp.broadcast_to(sink.astype(jnp.float32).reshape(AT_KV_HEADS, AT_GROUP, 1, 1),
                         logits.shape[:-1] + (1,))
    return jax.nn.softmax(jnp.concatenate([logits, s], axis=-1), axis=-1)[..., :-1]


def context_attention(qc, kc, vc, sink):
    b, n = qc.shape[:2]
    qg = qc.reshape(b, n, AT_KV_HEADS, AT_GROUP, HEAD_DIM)
    s = jnp.einsum("bqhgd,bkhd->bhgqk", qg, kc).astype(jnp.float32) * HEAD_DIM ** -0.5
    p = sink_softmax(s, sink).astype(vc.dtype)
    return jnp.einsum("bhgqk,bkhd->bqhgd", p, vc).reshape(b, n, AT_DIM)


def window_attention(q, k, v, kc, vc, sink):
    b, L = q.shape[:2]
    nb = L // BLOCK
    qb = q.reshape(b, nb, BLOCK, AT_KV_HEADS, AT_GROUP, HEAD_DIM)
    pad = ((0, 0), (BLOCK, BLOCK), (0, 0), (0, 0))
    kp = jnp.pad(k, pad).reshape(b, nb + 2, BLOCK, AT_KV_HEADS, HEAD_DIM)
    vp = jnp.pad(v, pad).reshape(b, nb + 2, BLOCK, AT_KV_HEADS, HEAD_DIM)
    kw = jnp.concatenate([kp[:, :-2], kp[:, 1:-1], kp[:, 2:]], axis=2)
    vw = jnp.concatenate([vp[:, :-2], vp[:, 1:-1], vp[:, 2:]], axis=2)
    scale = HEAD_DIM ** -0.5
    s_loc = jnp.einsum("bnqhgd,bnkhd->bnhgqk", qb, kw).astype(jnp.float32) * scale
    qpos = jnp.arange(nb)[:, None] * BLOCK + jnp.arange(BLOCK)[None, :]
    kpos = jnp.arange(nb)[:, None] * BLOCK - BLOCK + jnp.arange(3 * BLOCK)[None, :]
    valid = ((jnp.abs(qpos[:, :, None] - kpos[:, None, :]) <= WINDOW)
             & (kpos[:, None, :] >= 0) & (kpos[:, None, :] < L))
    s_loc = jnp.where(valid[None, :, None, None], s_loc, MASK_VALUE)
    s_ctx = jnp.einsum("bnqhgd,bkhd->bnhgqk", qb, kc).astype(jnp.float32) * scale
    p = sink_softmax(jnp.concatenate([s_loc, s_ctx], axis=-1), sink).astype(v.dtype)
    o = (jnp.einsum("bnhgqk,bnkhd->bnqhgd", p[..., :3 * BLOCK], vw)
         + jnp.einsum("bnhgqk,bkhd->bnqhgd", p[..., 3 * BLOCK:], vc))
    return o.reshape(b, L, AT_DIM)


def short_conv_branch(parts, cv_w):
    bg, cg, xin, g = parts
    u = jnp.pad(cg * xin, ((0, 0), (1, 1), (0, 0)))
    conv = u[:, :-2] * cv_w[0] + u[:, 1:-1] * cv_w[1] + u[:, 2:] * cv_w[2]
    return bg * conv * jax.nn.silu(g)


def hybrid_layer(x, xc, c, c_ctx, w_ada, b_ada, norm_g, w_in, w_out, rw_w0, rw_w_up, rw_a0,
                 rw_a_up, rw_k_k, rw_k_a, rw_r_k, rw_ln_g, rw_ln_b, at_sink, cv_w, cos, sin,
                 update_ctx):
    shift, scale, gate = jnp.split((jax.nn.silu(c) @ w_ada + b_ada)[:, None, :], 3, axis=-1)
    shift_c, scale_c, gate_c = jnp.split(jax.nn.silu(c_ctx) @ w_ada + b_ada, 3, axis=-1)
    h = rmsnorm(x, norm_g) * (1 + scale) + shift
    hc = rmsnorm(xc, norm_g) * (1 + scale_c) + shift_c
    offs = [int(o) for o in np.cumsum(IN_SPLITS)[:-1]]
    P = jnp.split(h @ w_in, offs, axis=-1)
    Pc = jnp.split(hc @ w_in, offs, axis=-1)
    rw_params = (rw_w0, rw_w_up, rw_a0, rw_a_up, rw_k_k, rw_k_a, rw_r_k, rw_ln_g, rw_ln_b)
    zeros = jnp.zeros((x.shape[0], RW_HEADS, HEAD_DIM, HEAD_DIM), jnp.float32)
    y_rw_c, s_ctx = rwkv7_branch(Pc[:6], *rw_params, (zeros, zeros))
    y_rw, _ = rwkv7_branch(P[:6], *rw_params, s_ctx)
    q = apply_rope(to_heads(P[6]), cos, sin)
    k = apply_rope(to_heads(P[7]), cos, sin)
    v = to_heads(P[8])
    qc, kc, vc = to_heads(Pc[6]), to_heads(Pc[7]), to_heads(Pc[8])
    y_at = window_attention(q, k, v, kc, vc, at_sink) * jax.nn.silu(P[9])
    y_cv = short_conv_branch(P[10:14], cv_w)
    x = x + gate * (jnp.concatenate([y_rw, y_at, y_cv], axis=-1) @ w_out)
    if update_ctx:
        y_at_c = context_attention(qc, kc, vc, at_sink) * jax.nn.silu(Pc[9])
        y_cv_c = short_conv_branch(Pc[10:14], cv_w)
        xc = xc + gate_c * (jnp.concatenate([y_rw_c, y_at_c, y_cv_c], axis=-1) @ w_out)
    return x, xc


def setup_inputs(seed: int = 0) -> dict:
    key = jax.random.key(seed)
    ks = jax.random.split(key, 24)
    f32 = jnp.float32
    n = jax.random.normal
    return {
        "x": n(ks[0], (BATCH, SEQ, D_MODEL), f32),
        "c": n(ks[1], (BATCH, D_MODEL), f32),
        "ctx": n(ks[2], (BATCH, CTX_LEN, D_MODEL), f32),
        "c_ctx": n(ks[3], (D_MODEL,), f32),
        "w_ada": n(ks[4], (DEPTH, D_MODEL, 3 * D_MODEL), f32) * (0.5 * D_MODEL ** -0.5),
        "b_ada": 0.02 * n(ks[5], (DEPTH, 3 * D_MODEL), f32),
        "norm_g": 1.0 + 0.02 * n(ks[6], (DEPTH, D_MODEL), f32),
        "w_in": n(ks[7], (DEPTH, D_MODEL, D_IN), f32) * D_MODEL ** -0.5,
        "w_out": n(ks[8], (DEPTH, D_MIX, D_MODEL), f32) * D_MIX ** -0.5,
        "rw_w0": jax.random.uniform(ks[9], (DEPTH, 2, RW_DIM), f32, -6.0, -1.0),
        "rw_w_up": n(ks[10], (DEPTH, 2, RW_LORA_W, RW_DIM), f32) * (0.5 * RW_LORA_W ** -0.5),
        "rw_a0": 0.1 * n(ks[11], (DEPTH, 2, RW_DIM), f32),
        "rw_a_up": n(ks[12], (DEPTH, 2, RW_LORA_A, RW_DIM), f32) * RW_LORA_A ** -0.5,
        "rw_k_k": 0.85 + 0.02 * n(ks[13], (DEPTH, RW_DIM), f32),
        "rw_k_a": 1.0 + 0.02 * n(ks[14], (DEPTH, RW_DIM), f32),
        "rw_r_k": 0.1 * n(ks[15], (DEPTH, RW_HEADS, HEAD_DIM), f32),
        "rw_ln_g": 1.0 + 0.02 * n(ks[16], (DEPTH, RW_DIM), f32),
        "rw_ln_b": 0.02 * n(ks[17], (DEPTH, RW_DIM), f32),
        "at_sink": 0.5 * n(ks[18], (DEPTH, AT_HEADS), f32),
        "cv_w": n(ks[19], (DEPTH, CONV_W, CV_DIM), f32) * CONV_W ** -0.5,
        "final_g": 1.0 + 0.02 * n(ks[20], (D_MODEL,), f32),
    }


def reference(x, c, ctx, c_ctx, w_ada, b_ada, norm_g, w_in, w_out, rw_w0, rw_w_up, rw_a0,
              rw_a_up, rw_k_k, rw_k_a, rw_r_k, rw_ln_g, rw_ln_b, at_sink, cv_w, final_g):
    L = x.shape[1]
    ROWS = L // GRID_W
    row = jnp.repeat(jnp.arange(ROWS), GRID_W)
    col = jnp.tile(jnp.arange(GRID_W), ROWS)
    cos, sin = axial_rope_tables(row, col)
    xc = ctx
    for l in range(DEPTH):
        x, xc = hybrid_layer(x, xc, c, c_ctx, w_ada[l], b_ada[l], norm_g[l], w_in[l], w_out[l],
                             rw_w0[l], rw_w_up[l], rw_a0[l], rw_a_up[l], rw_k_k[l], rw_k_a[l],
                             rw_r_k[l], rw_ln_g[l], rw_ln_b[l], at_sink[l], cv_w[l], cos, sin,
                             update_ctx=(l < DEPTH - 1))
    return rmsnorm(x, final_g)
```

```cpp
#include <hip/hip_runtime.h>
#include <hip/hip_bf16.h>
#include <hip/hip_cooperative_groups.h>
#include <cstdio>
namespace cg = cooperative_groups;

typedef unsigned short u16;
typedef __attribute__((ext_vector_type(8))) short bf16x8;
typedef __attribute__((ext_vector_type(4))) float f32x4;
typedef _Float16 h8 __attribute__((ext_vector_type(8)));
typedef _Float16 h4 __attribute__((ext_vector_type(4)));

#define DEVI __device__ __forceinline__

constexpr int PW = 3328;
constexpr size_t PROWB = 6656;
constexpr int MT = 16896;
constexpr int ML = 16384;
constexpr int C_R = 0, C_K = 384, C_G = 768, C_WD = 1152, C_AD = 1280, C_Q = 1408, C_KX = 1792,
              C_GA = 1920, C_BG = 2304, C_CG = 2560, C_XIN = 2816, C_GCV = 3072;
constexpr size_t OFF_P = 0;
constexpr size_t OFF_DI = 112459776;
constexpr size_t SZ_DI = 25952256;
constexpr size_t OFF_DD = OFF_DI + SZ_DI;
constexpr size_t SZ_DD1 = 38928384;
constexpr size_t OFF_V4 = OFF_DD + 2 * SZ_DD1;
constexpr size_t OFF_H = OFF_DI;
constexpr size_t OFF_WINT = OFF_DI + 116785152;
constexpr size_t OFF_WOUTT = OFF_WINT + 7864320;
constexpr size_t OFF_LORA = OFF_WOUTT + 2097152;
constexpr size_t OFF_MOD = OFF_LORA + 786432;
constexpr size_t OFF_XC = OFF_MOD + 147456;
constexpr size_t OFF_ROPE = OFF_XC + 2097152;
constexpr size_t OFF_VT = OFF_ROPE + 16384;
constexpr size_t OFF_VTC = OFF_VT + 4194304;
constexpr size_t OFF_BONUS = OFF_VTC + 131072;

constexpr int SCAN_BLOCKS = 192;

struct Params {
  const float *x, *c, *ctx, *c_ctx, *w_ada, *b_ada, *norm_g, *w_in, *w_out, *rw_w0, *rw_w_up, *rw_a0,
      *rw_a_up, *rw_k_k, *rw_k_a, *rw_r_k, *rw_ln_g, *rw_ln_b, *at_sink, *cv_w, *final_g;
  float* out;
  unsigned char* ws;
};

DEVI u16 f2bf(float f) {
  unsigned u = __float_as_uint(f);
  u += 0x7fffu + ((u >> 16) & 1u);
  return (u16)(u >> 16);
}
DEVI float bf2f(u16 h) { return __uint_as_float(((unsigned)h) << 16); }
DEVI unsigned pack2bf(float a, float b) { return (unsigned)f2bf(a) | ((unsigned)f2bf(b) << 16); }
DEVI float sigmoid_f(float x) { return 1.f / (1.f + __expf(-x)); }
DEVI float silu_f(float x) { return x / (1.f + __expf(-x)); }
DEVI float tanh_f(float x) { return 1.f - 2.f / (1.f + __expf(2.f * x)); }
DEVI f32x4 mfma16(bf16x8 a, bf16x8 b, f32x4 c) { return __builtin_amdgcn_mfma_f32_16x16x32_bf16(a, b, c, 0, 0, 0); }

DEVI int opaque_v(int x) { asm volatile("" : "+v"(x)); return x; }
DEVI int opaque_s(int x) { asm volatile("" : "+s"(x)); return x; }
#define TIDX opaque_v((int)threadIdx.x)
#define BIDX opaque_s((int)blockIdx.x)

template <int CTRL>
DEVI float dppf(float x) {
  return __int_as_float(__builtin_amdgcn_update_dpp(0, __float_as_int(x), CTRL, 0xF, 0xF, true));
}
DEVI float reduce32(float x) {
  x += dppf<0xB1>(x);
  x += dppf<0x4E>(x);
  x += dppf<0x141>(x);
  x += dppf<0x140>(x);
  x += __shfl_xor(x, 16);
  return x;
}
DEVI float reduce16(float x) {
  x += dppf<0xB1>(x);
  x += dppf<0x4E>(x);
  x += dppf<0x141>(x);
  x += dppf<0x140>(x);
  return x;
}

DEVI void transpose_tile(const float* __restrict__ src, int N, int K, int k0, int n0, u16* __restrict__ dst,
                         float* tile) {
  const int tid = TIDX;
  for (int e = tid; e < 4096; e += 256) {
    int r = e >> 6, cc = e & 63;
    tile[r * 65 + cc] = src[(size_t)(k0 + r) * N + n0 + cc];
  }
  __syncthreads();
  for (int e = tid; e < 4096; e += 256) {
    int n = e >> 6, k = e & 63;
    dst[(size_t)(n0 + n) * K + k0 + k] = f2bf(tile[k * 65 + n]);
  }
  __syncthreads();
}
DEVI void convert_weight(const float* src, int K, int N, u16* dst, float* tile, int t0, int stride) {
  const int nk = K >> 6, nn = N >> 6;
  for (int t = t0; t < nk * nn; t += stride) transpose_tile(src, N, K, (t % nk) * 64, (t / nk) * 64, dst, tile);
}

DEVI void mod_task(const Params& p, int task, float* sm) {
  const int l = task / 48, n0 = (task % 48) * 64;
  const int tid = TIDX;
  for (int e = tid; e < 3072; e += 256) {
    int bi = e >> 10, k = e & 1023;
    float v = bi < 2 ? p.c[bi * 1024 + k] : p.c_ctx[k];
    sm[e] = silu_f(v);
  }
  __syncthreads();
  const int col = tid & 63, kg = tid >> 6;
  const float* w = p.w_ada + (size_t)l * 1024 * 3072 + n0 + col;
  float a0 = 0.f, a1 = 0.f, a2 = 0.f;
#pragma unroll 8
  for (int k = kg * 256; k < kg * 256 + 256; ++k) {
    float wv = w[(size_t)k * 3072];
    a0 += sm[k] * wv;
    a1 += sm[1024 + k] * wv;
    a2 += sm[2048 + k] * wv;
  }
  float* red = sm + 3072;
  red[(kg * 3 + 0) * 64 + col] = a0;
  red[(kg * 3 + 1) * 64 + col] = a1;
  red[(kg * 3 + 2) * 64 + col] = a2;
  __syncthreads();
  if (tid < 192) {
    int bi = tid >> 6, cc = tid & 63;
    float s = p.b_ada[l * 3072 + n0 + cc];
    for (int q = 0; q < 4; ++q) s += red[(q * 3 + bi) * 64 + cc];
    float* mod = (float*)(p.ws + OFF_MOD);
    mod[(l * 3 + bi) * 3072 + n0 + cc] = s;
  }
  __syncthreads();
}

DEVI void prologue_phase(const Params& p, unsigned char* smem) {
  float* tile = (float*)smem;
  const int bid = BIDX;
  convert_weight(p.w_in, 1024, 3840, (u16*)(p.ws + OFF_WINT), tile, bid, gridDim.x);
  for (int t = bid; t < 96; t += gridDim.x) {
    int ct = t % 6, mat = t / 6;
    int kind = mat & 1, ld = mat >> 1;
    const float* src = (kind ? p.rw_a_up : p.rw_w_up) + (size_t)ld * 64 * 384;
    transpose_tile(src, 384, 64, 0, ct * 64, (u16*)(p.ws + OFF_LORA) + (size_t)mat * 384 * 64, tile);
  }
  for (int t = bid; t < 192; t += gridDim.x) mod_task(p, t, tile);
  if (bid == (int)gridDim.x - 1) {
    float* rope = (float*)(p.ws + OFF_ROPE);
    for (int e = TIDX; e < 2048; e += 256) {
      int pos = e >> 4, f = e & 15;
      float inv = exp2f(-(float)f * (13.287712379549449f / 16.f));
      float ang = (float)pos * inv;
      rope[e * 2] = cosf(ang);
      rope[e * 2 + 1] = sinf(ang);
    }
  }
}

DEVI void norm_phase(const Params& p, int l) {
  const int tid = TIDX;
  const int lane = tid & 63;
  const int gw = BIDX * 4 + (tid >> 6), nw = gridDim.x * 4;
  const float* xs = l == 0 ? p.x : p.out;
  const float* xcs = l == 0 ? p.ctx : (const float*)(p.ws + OFF_XC);
  const float* mod = (const float*)(p.ws + OFF_MOD) + (size_t)l * 3 * 3072;
  const float* ng = p.norm_g + l * 1024;
  u16* H = (u16*)(p.ws + OFF_H);
  for (int m = gw; m < MT; m += nw) {
    const float* row = m < ML ? xs + (size_t)m * 1024 : xcs + (size_t)(m - ML) * 1024;
    const int bi = m < 8192 ? 0 : (m < ML ? 1 : 2);
    float4 v[4];
    float ss = 0.f;
#pragma unroll
    for (int i = 0; i < 4; ++i) {
      v[i] = *(const float4*)(row + i * 256 + lane * 4);
      ss += v[i].x * v[i].x + v[i].y * v[i].y + v[i].z * v[i].z + v[i].w * v[i].w;
    }
#pragma unroll
    for (int o = 32; o > 0; o >>= 1) ss += __shfl_xor(ss, o);
    const float inv = rsqrtf(ss * (1.f / 1024.f) + 1e-6f);
    const float* md = mod + bi * 3072;
#pragma unroll
    for (int i = 0; i < 4; ++i) {
      const int c0 = i * 256 + lane * 4;
      float4 g4 = *(const float4*)(ng + c0);
      float4 sh = *(const float4*)(md + c0);
      float4 sc = *(const float4*)(md + 1024 + c0);
      float o0 = v[i].x * inv * g4.x * (1.f + sc.x) + sh.x;
      float o1 = v[i].y * inv * g4.y * (1.f + sc.y) + sh.y;
      float o2 = v[i].z * inv * g4.z * (1.f + sc.z) + sh.z;
      float o3 = v[i].w * inv * g4.w * (1.f + sc.w) + sh.w;
      uint2 pk;
      pk.x = pack2bf(o0, o1);
      pk.y = pack2bf(o2, o3);
      *(uint2*)(H + (size_t)m * 1024 + c0) = pk;
    }
  }
}

template <int MODE>
DEVI void gemm_phase(const Params& p, int l, unsigned char* smem) {
  u16* sA = (u16*)smem;
  u16* sB = sA + 128 * 72;
  const int tid = TIDX, lane = tid & 63, wave = tid >> 6, wm = wave >> 1, wn = wave & 1;
  const int fr = lane & 15, g = lane >> 4;
  const int ntn = MODE == 0 ? 30 : 8;
  const int ntm = MODE == 0 ? 132 : (l < 3 ? 132 : 128);
  const u16* A = MODE == 0 ? (const u16*)(p.ws + OFF_H) : (const u16*)(p.ws + OFF_P);
  const int lda = MODE == 0 ? 1024 : PW;
  const u16* Bt = MODE == 0 ? (const u16*)(p.ws + OFF_WINT) : (const u16*)(p.ws + OFF_WOUTT);
  u16* P = (u16*)(p.ws + OFF_P);

  for (int t = BIDX; t < ntm * ntn; t += gridDim.x) {
    const int tn = t % ntn, tm = t / ntn;
    const int m0 = tm * 128, n0 = tn * 128;
    bool TR = true;
    if (MODE == 0) TR = !((tn >= 6 && tn < 9) || tn == 18);
    const u16* s1 = TR ? sB : sA;
    const u16* s2 = TR ? sA : sB;
    const int w1 = (TR ? wn : wm) * 64, w2 = (TR ? wm : wn) * 64;

    f32x4 acc[4][4];
#pragma unroll
    for (int i = 0; i < 4; ++i)
#pragma unroll
      for (int j = 0; j < 4; ++j) acc[i][j] = f32x4{0.f, 0.f, 0.f, 0.f};

    uint4 ra0, ra1, ra2, ra3, rb0, rb1, rb2, rb3;
    const int lrow = tid >> 3, lseg = tid & 7;
    const u16* aptr = A + (size_t)(m0 + lrow) * lda + lseg * 8;
    const u16* bptr = Bt + (size_t)(n0 + lrow) * 1024 + lseg * 8;
    u16* sAw = sA + lrow * 72 + lseg * 8;
    u16* sBw = sB + lrow * 72 + lseg * 8;
#define ACOL(kt) (MODE == 0 ? (kt) * 64 : ((kt) < 6 ? C_G + (kt) * 64 : ((kt) < 12 ? C_GA + ((kt) - 6) * 64 : C_BG + ((kt) - 12) * 64)))
#define GLOAD(kt)                                                              \
  {                                                                            \
    const int acol_ = ACOL(kt);                                                \
    ra0 = *(const uint4*)(aptr + acol_);                                       \
    ra1 = *(const uint4*)(aptr + (size_t)32 * lda + acol_);                    \
    ra2 = *(const uint4*)(aptr + (size_t)64 * lda + acol_);                    \
    ra3 = *(const uint4*)(aptr + (size_t)96 * lda + acol_);                    \
    rb0 = *(const uint4*)(bptr + (kt) * 64);                                   \
    rb1 = *(const uint4*)(bptr + 32 * 1024 + (kt) * 64);                       \
    rb2 = *(const uint4*)(bptr + 64 * 1024 + (kt) * 64);                       \
    rb3 = *(const uint4*)(bptr + 96 * 1024 + (kt) * 64);                       \
  }
#define SSTORE()                                                               \
  {                                                                            \
    *(uint4*)(sAw) = ra0;                                                      \
    *(uint4*)(sAw + 32 * 72) = ra1;                                            \
    *(uint4*)(sAw + 64 * 72) = ra2;                                            \
    *(uint4*)(sAw + 96 * 72) = ra3;                                            \
    *(uint4*)(sBw) = rb0;                                                      \
    *(uint4*)(sBw + 32 * 72) = rb1;                                            \
    *(uint4*)(sBw + 64 * 72) = rb2;                                            \
    *(uint4*)(sBw + 96 * 72) = rb3;                                            \
  }
    GLOAD(0);
    SSTORE();
    __syncthreads();
#pragma unroll 1
    for (int kt = 0; kt < 16; ++kt) {
      if (kt < 15) GLOAD(kt + 1);
#pragma unroll
      for (int s = 0; s < 2; ++s) {
        bf16x8 f1[4], f2[4];
#pragma unroll
        for (int i = 0; i < 4; ++i) {
          f1[i] = *(const bf16x8*)(s1 + (w1 + i * 16 + fr) * 72 + s * 32 + g * 8);
          f2[i] = *(const bf16x8*)(s2 + (w2 + i * 16 + fr) * 72 + s * 32 + g * 8);
        }
#pragma unroll
        for (int i = 0; i < 4; ++i)
#pragma unroll
          for (int j = 0; j < 4; ++j) acc[i][j] = mfma16(f1[i], f2[j], acc[i][j]);
      }
      __syncthreads();
      if (kt < 15) {
        SSTORE();
        __syncthreads();
      }
    }
#undef GLOAD
#undef SSTORE
#undef ACOL

    if (MODE == 1) {
      const float* mod = (const float*)(p.ws + OFF_MOD) + (size_t)l * 3 * 3072;
#pragma unroll
      for (int b2 = 0; b2 < 4; ++b2) {
        const int m = m0 + wm * 64 + b2 * 16 + fr;
        const int bi = m < 8192 ? 0 : (m < ML ? 1 : 2);
        const float* src;
        float* dst;
        if (m < ML) {
          src = (l == 0 ? p.x : p.out) + (size_t)m * 1024;
          dst = p.out + (size_t)m * 1024;
        } else {
          src = (l == 0 ? p.ctx : (const float*)(p.ws + OFF_XC)) + (size_t)(m - ML) * 1024;
          dst = (float*)(p.ws + OFF_XC) + (size_t)(m - ML) * 1024;
        }
#pragma unroll
        for (int a = 0; a < 4; ++a) {
          const int n = n0 + wn * 64 + a * 16 + 4 * g;
          float4 xo = *(const float4*)(src + n);
          float4 gt = *(const float4*)(mod + bi * 3072 + 2048 + n);
          float4 o;
          o.x = xo.x + gt.x * acc[a][b2][0];
          o.y = xo.y + gt.y * acc[a][b2][1];
          o.z = xo.z + gt.z * acc[a][b2][2];
          o.w = xo.w + gt.w * acc[a][b2][3];
          *(float4*)(dst + n) = o;
        }
      }
    } else {
      const int nbase = n0 + wn * 64;
      if (!TR) {
        if (tn == 18) {
#pragma unroll
          for (int mt = 0; mt < 4; ++mt) {
            const int mb = m0 + wm * 64 + mt * 16 + 4 * g;
#pragma unroll
            for (int nt = 0; nt < 4; ++nt) {
              const int hc = nbase - 2304 + nt * 16 + fr;
              const int kvh = hc >> 6, d = hc & 63;
              uint2 pk;
              pk.x = pack2bf(acc[mt][nt][0], acc[mt][nt][1]);
              pk.y = pack2bf(acc[mt][nt][2], acc[mt][nt][3]);
              if (mb < ML) {
                const int b = mb >> 13, tk = mb & 8191;
                u16* dst = (u16*)(p.ws + OFF_VT) + ((size_t)((b * 2 + kvh) * 64 + d)) * 8192 + tk;
                *(uint2*)dst = pk;
              } else {
                const int mm = mb - ML, b = mm >> 8, tk = mm & 255;
                u16* dst = (u16*)(p.ws + OFF_VTC) + ((size_t)((b * 2 + kvh) * 64 + d)) * 256 + tk;
                *(uint2*)dst = pk;
              }
            }
          }
        } else {
#pragma unroll
          for (int mt = 0; mt < 4; ++mt) {
            const int tg = ((m0 + wm * 64 + mt * 16) >> 2) + g;
#pragma unroll
            for (int nt = 0; nt < 4; ++nt) {
              const int hc = nbase - 768 + nt * 16 + fr;
              const int h = hc >> 6, rv = hc & 63;
              h4 hv;
              hv[0] = (_Float16)acc[mt][nt][0];
              hv[1] = (_Float16)acc[mt][nt][1];
              hv[2] = (_Float16)acc[mt][nt][2];
              hv[3] = (_Float16)acc[mt][nt][3];
              *(h4*)(p.ws + OFF_V4 + ((size_t)(tg * 6 + h) * 64 + rv) * 8) = hv;
            }
          }
        }
      } else {
        const int pc = nbase < 768 ? nbase : (nbase < 2304 ? nbase - 384 : nbase - 512);
        const bool rope = (tn >= 14 && tn < 18);
        const float* ropeT = (const float*)(p.ws + OFF_ROPE);
#pragma unroll
        for (int b2 = 0; b2 < 4; ++b2) {
          const int m = m0 + wm * 64 + b2 * 16 + fr;
          if (rope && m < ML) {
            const int tk = m & 8191;
#pragma unroll
            for (int a = 0; a < 2; ++a) {
              const int pos = a == 0 ? (tk >> 6) : (tk & 63);
#pragma unroll
              for (int i = 0; i < 4; ++i) {
                const int f = 4 * g + i;
                const float cs = ropeT[(pos * 16 + f) * 2], sn = ropeT[(pos * 16 + f) * 2 + 1];
                const float t1 = acc[a][b2][i], t2 = acc[a + 2][b2][i];
                acc[a][b2][i] = t1 * cs - t2 * sn;
                acc[a + 2][b2][i] = t1 * sn + t2 * cs;
              }
            }
          }
          if (tn == 12) {
#pragma unroll
            for (int a = 0; a < 4; ++a)
#pragma unroll
              for (int i = 0; i < 4; ++i) acc[a][b2][i] = tanh_f(acc[a][b2][i]);
          }
#pragma unroll
          for (int a = 0; a < 4; ++a) {
            uint2 pk;
            pk.x = pack2bf(acc[a][b2][0], acc[a][b2][1]);
            pk.y = pack2bf(acc[a][b2][2], acc[a][b2][3]);
            *(uint2*)(P + (size_t)m * PW + pc + a * 16 + 4 * g) = pk;
          }
        }
      }
    }
  }
}

DEVI void prep_wave_task(const Params& p, int l, int m0, int h, int lane) {
  const int fr = lane & 15, g = lane >> 4;
  const u16* P = (const u16*)(p.ws + OFF_P);
  const u16* Prow = P + (size_t)(m0 + fr) * PW;
  float kf[4][4], rf[4][4], kkv[4][4];
  float kkp[4], kap[4], rkp[4];
#pragma unroll
  for (int nt = 0; nt < 4; ++nt) {
    const int c = h * 64 + nt * 16 + fr;
    kkp[nt] = p.rw_k_k[l * 384 + c];
    kap[nt] = p.rw_k_a[l * 384 + c];
    rkp[nt] = p.rw_r_k[l * 384 + c];
  }
  float ss[4], bs[4];
#pragma unroll
  for (int i = 0; i < 4; ++i) {
    const u16* q = P + (size_t)(m0 + 4 * g + i) * PW;
    ss[i] = 0.f;
    bs[i] = 0.f;
#pragma unroll
    for (int nt = 0; nt < 4; ++nt) {
      const int c = h * 64 + nt * 16 + fr;
      kf[i][nt] = bf2f(q[C_K + c]);
      rf[i][nt] = bf2f(q[C_R + c]);
      const float kr = kf[i][nt] * kkp[nt];
      kkv[i][nt] = kr;
      ss[i] += kr * kr;
      bs[i] += rf[i][nt] * kf[i][nt] * rkp[nt];
    }
    ss[i] = reduce16(ss[i]);
    bs[i] = reduce16(bs[i]);
    const float rn = rsqrtf(fmaxf(ss[i], 1e-12f));
#pragma unroll
    for (int nt = 0; nt < 4; ++nt) kkv[i][nt] *= rn;
    if (fr == 0) ((float*)(p.ws + OFF_BONUS))[(size_t)(m0 + 4 * g + i) * 6 + h] = bs[i];
  }
  const int tg = (m0 >> 2) + g;
#pragma unroll
  for (int nt = 0; nt < 4; ++nt) {
    const int c = nt * 16 + fr;
    unsigned char* base = p.ws + OFF_DI + ((size_t)(tg * 6 + h) * 64 + c) * 16;
    h4 a, b;
#pragma unroll
    for (int i = 0; i < 4; ++i) {
      a[i] = (_Float16)kkv[i][nt];
      b[i] = (_Float16)rf[i][nt];
    }
    *(h4*)base = a;
    *(h4*)(base + 8) = b;
  }
  const u16* LT = (const u16*)(p.ws + OFF_LORA);
#pragma unroll 1
  for (int d = 0; d < 2; ++d) {
    f32x4 accw[4], acca[4];
#pragma unroll
    for (int nt = 0; nt < 4; ++nt) {
      accw[nt] = f32x4{0.f, 0.f, 0.f, 0.f};
      acca[nt] = f32x4{0.f, 0.f, 0.f, 0.f};
    }
#pragma unroll
    for (int s = 0; s < 2; ++s) {
      const bf16x8 aw = *(const bf16x8*)(Prow + C_WD + d * 64 + s * 32 + g * 8);
      const bf16x8 aa = *(const bf16x8*)(Prow + C_AD + d * 64 + s * 32 + g * 8);
#pragma unroll
      for (int nt = 0; nt < 4; ++nt) {
        const size_t rw = (size_t)(h * 64 + nt * 16 + fr) * 64 + s * 32 + g * 8;
        const bf16x8 bw = *(const bf16x8*)(LT + (size_t)((l * 2 + d) * 2 + 0) * 384 * 64 + rw);
        const bf16x8 ba = *(const bf16x8*)(LT + (size_t)((l * 2 + d) * 2 + 1) * 384 * 64 + rw);
        accw[nt] = mfma16(aw, bw, accw[nt]);
        acca[nt] = mfma16(aa, ba, acca[nt]);
      }
    }
#pragma unroll
    for (int nt = 0; nt < 4; ++nt) {
      const int cl = nt * 16 + fr, c = h * 64 + cl;
      const float w0 = p.rw_w0[(l * 2 + d) * 384 + c];
      const float a0 = p.rw_a0[(l * 2 + d) * 384 + c];
      h4 hu, hn, hk;
#pragma unroll
      for (int i = 0; i < 4; ++i) {
        const float sig = sigmoid_f(w0 + accw[nt][i]);
        const float u = 1.f - __expf(-0.60653066f * sig);
        const float av = sigmoid_f(a0 + acca[nt][i]);
        hu[i] = (_Float16)u;
        hn[i] = (_Float16)(-kkv[i][nt] * av);
        hk[i] = (_Float16)(kf[i][nt] * (1.f + (av - 1.f) * kap[nt]));
      }
      unsigned char* base = p.ws + OFF_DD + (size_t)d * SZ_DD1 + ((size_t)(tg * 6 + h) * 64 + cl) * 24;
      *(h4*)base = hu;
      *(h4*)(base + 8) = hn;
      *(h4*)(base + 16) = hk;
    }
  }
}

DEVI void prep_phase(const Params& p, int l, unsigned char* smem) {
  const int tid = TIDX, lane = tid & 63, wave = tid >> 6;
  const int bid = BIDX;
  u16* P = (u16*)(p.ws + OFF_P);
  for (int tile = bid; tile < MT / 32; tile += gridDim.x) {
    for (int wt = wave; wt < 12; wt += 4) prep_wave_task(p, l, tile * 32 + (wt / 6) * 16, wt % 6, lane);
#pragma unroll 1
    for (int it = 0; it < 4; ++it) {
      const int item = tid + 256 * it;
      const int tok = item >> 5, ch = (item & 31) * 8;
      const int m = tile * 32 + tok;
      int pos, last;
      if (m < ML) { pos = m & 8191; last = 8191; } else { pos = (m - ML) & 255; last = 255; }
      const u16* row = P + (size_t)m * PW;
      float uc[8], up[8], un[8];
      {
        bf16x8 a = *(const bf16x8*)(row + C_CG + ch), b = *(const bf16x8*)(row + C_XIN + ch);
#pragma unroll
        for (int e = 0; e < 8; ++e) uc[e] = bf2f((u16)a[e]) * bf2f((u16)b[e]);
      }
      if (pos > 0) {
        bf16x8 a = *(const bf16x8*)(row - PW + C_CG + ch), b = *(const bf16x8*)(row - PW + C_XIN + ch);
#pragma unroll
        for (int e = 0; e < 8; ++e) up[e] = bf2f((u16)a[e]) * bf2f((u16)b[e]);
      } else {
#pragma unroll
        for (int e = 0; e < 8; ++e) up[e] = 0.f;
      }
      if (pos < last) {
        bf16x8 a = *(const bf16x8*)(row + PW + C_CG + ch), b = *(const bf16x8*)(row + PW + C_XIN + ch);
#pragma unroll
        for (int e = 0; e < 8; ++e) un[e] = bf2f((u16)a[e]) * bf2f((u16)b[e]);
      } else {
#pragma unroll
        for (int e = 0; e < 8; ++e) un[e] = 0.f;
      }
      bf16x8 bg = *(const bf16x8*)(row + C_BG + ch), gc = *(const bf16x8*)(row + C_GCV + ch);
      const float* cw = p.cv_w + l * 768;
      unsigned o[4];
#pragma unroll
      for (int e = 0; e < 8; e += 2) {
        float y0 = up[e] * cw[ch + e] + uc[e] * cw[256 + ch + e] + un[e] * cw[512 + ch + e];
        float y1 = up[e + 1] * cw[ch + e + 1] + uc[e + 1] * cw[256 + ch + e + 1] + un[e + 1] * cw[512 + ch + e + 1];
        y0 = bf2f((u16)bg[e]) * y0 * silu_f(bf2f((u16)gc[e]));
        y1 = bf2f((u16)bg[e + 1]) * y1 * silu_f(bf2f((u16)gc[e + 1]));
        o[e >> 1] = pack2bf(y0, y1);
      }
      *(uint4*)(P + (size_t)m * PW + C_BG + ch) = uint4{o[0], o[1], o[2], o[3]};
    }
    __syncthreads();
#pragma unroll 1
    for (int it = 0; it < 12; ++it) {
      const int item = tid + 256 * it;
      const int tok = item / 96, q = item % 96;
      *(float4*)((unsigned char*)P + (size_t)(tile * 32 + tok) * PROWB + q * 16) = float4{0.f, 0.f, 0.f, 0.f};
    }
    __syncthreads();
  }
  float* tilef = (float*)smem;
  convert_weight(p.w_out + (size_t)l * 1024 * 1024, 1024, 1024, (u16*)(p.ws + OFF_WOUTT), tilef, bid, gridDim.x);
  if (l < 3)
    convert_weight(p.w_in + (size_t)(l + 1) * 1024 * 3840, 1024, 3840, (u16*)(p.ws + OFF_WINT), tilef, bid,
                   gridDim.x);
}

template <int DIR>
DEVI void scan_chain(const Params& p, int b, int h, int pr, int lane) {
  const int rs = lane >> 5, kp = lane & 31, row = 2 * pr + rs;
  const unsigned char* DI = p.ws + OFF_DI;
  const unsigned char* DD = p.ws + OFF_DD + (size_t)DIR * SZ_DD1;
  const unsigned char* V4 = p.ws + OFF_V4;
  auto tgof = [&](int gi) -> int {
    if (gi < 64) return 4096 + b * 64 + (DIR ? 63 - gi : gi);
    const int tl = gi - 64;
    return b * 2048 + (DIR ? 2047 - tl : tl);
  };
  float S0 = 0.f, S1 = 0.f;
  int tgn = tgof(0);
  h8 nd0, nd1, ne0, ne1, ne2;
  h4 nv;
  {
    const size_t blk = (size_t)(tgn * 6 + h) * 64;
    const unsigned char* a = DI + (blk + 2 * kp) * 16;
    nd0 = *(const h8*)a;
    nd1 = *(const h8*)(a + 16);
    const unsigned char* e = DD + (blk + 2 * kp) * 24;
    ne0 = *(const h8*)e;
    ne1 = *(const h8*)(e + 16);
    ne2 = *(const h8*)(e + 32);
    nv = *(const h4*)(V4 + (blk + row) * 8);
  }
#pragma unroll 1
  for (int gi = 0; gi < 2112; ++gi) {
    const h8 d0 = nd0, d1 = nd1, e0 = ne0, e1 = ne1, e2 = ne2;
    const h4 vv = nv;
    const int tgc = tgn;
    {
      const int gn = gi + 1 < 2112 ? gi + 1 : 2111;
      tgn = tgof(gn);
      const size_t blk = (size_t)(tgn * 6 + h) * 64;
      const unsigned char* a = DI + (blk + 2 * kp) * 16;
      nd0 = *(const h8*)a;
      nd1 = *(const h8*)(a + 16);
      const unsigned char* e = DD + (blk + 2 * kp) * 24;
      ne0 = *(const h8*)e;
      ne1 = *(const h8*)(e + 16);
      ne2 = *(const h8*)(e + 32);
      nv = *(const h4*)(V4 + (blk + row) * 8);
    }
    float y[4];
#pragma unroll
    for (int jj = 0; jj < 4; ++jj) {
      const int j = DIR ? 3 - jj : jj;
      const float kk0 = (float)d0[j], r0 = (float)d0[4 + j], kk1 = (float)d1[j], r1 = (float)d1[4 + j];
      const float u0 = (float)e0[j], nk0 = (float)e0[4 + j], kd0 = (float)e1[j];
      const float u1 = (float)e1[4 + j], nk1 = (float)e2[j], kd1 = (float)e2[4 + j];
      const float v = (float)vv[j];
      const float sa = reduce32(fmaf(kk1, S1, kk0 * S0));
      float T0 = fmaf(-u0, S0, S0), T1 = fmaf(-u1, S1, S1);
      T0 = fmaf(v, kd0, T0);
      T1 = fmaf(v, kd1, T1);
      S0 = fmaf(sa, nk0, T0);
      S1 = fmaf(sa, nk1, T1);
      y[jj] = reduce32(fmaf(r1, S1, r0 * S0));
    }
    if (kp < 4) {
      const int j = DIR ? 3 - kp : kp;
      const float yv = kp == 0 ? y[0] : (kp == 1 ? y[1] : (kp == 2 ? y[2] : y[3]));
      float* dst = (float*)(p.ws + OFF_P + (size_t)(4 * tgc + j) * PROWB) + h * 64 + row;
      unsafeAtomicAdd(dst, yv);
    }
  }
}

DEVI void attn_task(const Params& p, int l, int task, int lane) {
  const int fr = lane & 15, g = lane >> 4;
  u16* P = (u16*)(p.ws + OFF_P);
  const bool isctx = task >= 2048;
  int b, kvh, qt;
  if (!isctx) { qt = task & 511; kvh = (task >> 9) & 1; b = task >> 10; }
  else { const int t2 = task - 2048; qt = t2 & 15; kvh = (t2 >> 4) & 1; b = t2 >> 5; }
  const int q0 = qt * 16;
  const size_t qrow = isctx ? (size_t)(ML + b * 256 + q0 + fr) : (size_t)(b * 8192 + q0 + fr);
  u16* Pq = P + qrow * PW;
  bf16x8 qf[3][2];
#pragma unroll
  for (int hq = 0; hq < 3; ++hq)
#pragma unroll
    for (int s = 0; s < 2; ++s) qf[hq][s] = *(const bf16x8*)(Pq + C_Q + (kvh * 3 + hq) * 64 + s * 32 + g * 8);
  float mrun[3], lpart[3];
  f32x4 O[3][4];
#pragma unroll
  for (int hq = 0; hq < 3; ++hq) {
    mrun[hq] = p.at_sink[l * 6 + kvh * 3 + hq];
    lpart[hq] = g == 0 ? 1.f : 0.f;
#pragma unroll
    for (int dt = 0; dt < 4; ++dt) O[hq][dt] = f32x4{0.f, 0.f, 0.f, 0.f};
  }
  const int nwin = isctx ? 0 : 9;
  const u16* VT = (const u16*)(p.ws + OFF_VT) + (size_t)((b * 2 + kvh) * 64) * 8192;
  const u16* VTC = (const u16*)(p.ws + OFF_VTC) + (size_t)((b * 2 + kvh) * 64) * 256;
#pragma unroll 1
  for (int it = 0; it < nwin + 8; ++it) {
    const bool win = it < nwin;
    const int kb = win ? (q0 - 128 + 32 * it) : 32 * (it - nwin);
    bf16x8 kf[2][2];
#pragma unroll
    for (int tt = 0; tt < 2; ++tt) {
      const int key = kb + 16 * tt + fr;
      size_t krow;
      if (win) { const int kc = key < 0 ? 0 : (key > 8191 ? 8191 : key); krow = (size_t)(b * 8192 + kc); }
      else krow = (size_t)(ML + b * 256 + key);
#pragma unroll
      for (int s = 0; s < 2; ++s) kf[tt][s] = *(const bf16x8*)(P + krow * PW + C_KX + kvh * 64 + s * 32 + g * 8);
    }
    bf16x8 vf[4];
#pragma unroll
    for (int dt = 0; dt < 4; ++dt) {
      const int d = dt * 16 + fr;
      uint2 lo, hi;
      if (win) {
        int k1 = kb + 4 * g, k2 = kb + 16 + 4 * g;
        if (k1 < 0 || k1 > 8188) k1 = 0;
        if (k2 < 0 || k2 > 8188) k2 = 0;
        lo = *(const uint2*)(VT + (size_t)d * 8192 + k1);
        hi = *(const uint2*)(VT + (size_t)d * 8192 + k2);
      } else {
        lo = *(const uint2*)(VTC + d * 256 + kb + 4 * g);
        hi = *(const uint2*)(VTC + d * 256 + kb + 16 + 4 * g);
      }
      uint4 cmb = uint4{lo.x, lo.y, hi.x, hi.y};
      vf[dt] = __builtin_bit_cast(bf16x8, cmb);
    }
#pragma unroll
    for (int hq = 0; hq < 3; ++hq) {
      f32x4 sa = f32x4{0.f, 0.f, 0.f, 0.f}, sb = f32x4{0.f, 0.f, 0.f, 0.f};
#pragma unroll
      for (int s = 0; s < 2; ++s) {
        sa = mfma16(kf[0][s], qf[hq][s], sa);
        sb = mfma16(kf[1][s], qf[hq][s], sb);
      }
      float sv[8];
#pragma unroll
      for (int i = 0; i < 4; ++i) {
        sv[i] = sa[i] * 0.125f;
        sv[4 + i] = sb[i] * 0.125f;
      }
      if (win) {
        const int qpos = q0 + fr;
#pragma unroll
        for (int i = 0; i < 8; ++i) {
          const int kpos = kb + 4 * g + (i & 3) + (i >> 2) * 16;
          const int df = qpos - kpos;
          const bool ok = kpos >= 0 && kpos < 8192 && df <= 128 && df >= -128;
          if (!ok) sv[i] = -1e30f;
        }
      }
      float tmax = sv[0];
#pragma unroll
      for (int i = 1; i < 8; ++i) tmax = fmaxf(tmax, sv[i]);
      tmax = fmaxf(tmax, __shfl_xor(tmax, 16));
      tmax = fmaxf(tmax, __shfl_xor(tmax, 32));
      const float mnew = fmaxf(mrun[hq], tmax);
      const float alpha = __expf(mrun[hq] - mnew);
      mrun[hq] = mnew;
      float ps = 0.f, pv[8];
#pragma unroll
      for (int i = 0; i < 8; ++i) {
        pv[i] = __expf(sv[i] - mnew);
        ps += pv[i];
      }
      lpart[hq] = lpart[hq] * alpha + ps;
      uint4 pk = uint4{pack2bf(pv[0], pv[1]), pack2bf(pv[2], pv[3]), pack2bf(pv[4], pv[5]), pack2bf(pv[6], pv[7])};
      const bf16x8 pf = __builtin_bit_cast(bf16x8, pk);
#pragma unroll
      for (int dt = 0; dt < 4; ++dt) {
        O[hq][dt] *= alpha;
        O[hq][dt] = mfma16(vf[dt], pf, O[hq][dt]);
      }
    }
  }
#pragma unroll
  for (int hq = 0; hq < 3; ++hq) {
    float lt = lpart[hq] + __shfl_xor(lpart[hq], 16);
    lt += __shfl_xor(lt, 32);
    const float inv = 1.f / lt;
#pragma unroll
    for (int dt = 0; dt < 4; ++dt) {
      u16* dst = Pq + C_GA + (kvh * 3 + hq) * 64 + dt * 16 + 4 * g;
      const uint2 gt = *(const uint2*)dst;
      const float g0 = bf2f((u16)(gt.x & 0xffff)), g1 = bf2f((u16)(gt.x >> 16));
      const float g2 = bf2f((u16)(gt.y & 0xffff)), g3 = bf2f((u16)(gt.y >> 16));
      uint2 o;
      o.x = pack2bf(O[hq][dt][0] * inv * silu_f(g0), O[hq][dt][1] * inv * silu_f(g1));
      o.y = pack2bf(O[hq][dt][2] * inv * silu_f(g2), O[hq][dt][3] * inv * silu_f(g3));
      *(uint2*)dst = o;
    }
  }
}

DEVI void mix_phase(const Params& p, int l) {
  const int tid = TIDX, bid = BIDX;
  const int lane = tid & 63, wave = tid >> 6;
  if (bid < SCAN_BLOCKS) {
    const int w = bid * 4 + wave;
    const int chain = w >> 5, pr = w & 31;
    const int dir = chain & 1, h = (chain >> 1) % 6, b = chain / 12;
    if (dir == 0) scan_chain<0>(p, b, h, pr, lane);
    else scan_chain<1>(p, b, h, pr, lane);
  } else {
    const int aw = (bid - SCAN_BLOCKS) * 4 + wave, naw = ((int)gridDim.x - SCAN_BLOCKS) * 4;
    const int ntask = 2048 + (l < 3 ? 64 : 0);
    for (int t = aw; t < ntask; t += naw) attn_task(p, l, t, lane);
  }
}

DEVI void post_phase(const Params& p, int l) {
  const int nrows = l < 3 ? MT : ML;
  const int total = nrows * 6;
  for (int it = BIDX * 256 + TIDX; it < total; it += gridDim.x * 256) {
    const int m = it / 6, h = it % 6;
    unsigned char* rowb = p.ws + OFF_P + (size_t)m * PROWB;
    const float* ya = (const float*)rowb + h * 64;
    float y[64];
    float mu = 0.f;
#pragma unroll
    for (int q = 0; q < 16; ++q) {
      const float4 t = *(const float4*)(ya + q * 4);
      y[q * 4] = t.x; y[q * 4 + 1] = t.y; y[q * 4 + 2] = t.z; y[q * 4 + 3] = t.w;
      mu += t.x + t.y + t.z + t.w;
    }
    mu *= (1.f / 64.f);
    float var = 0.f;
#pragma unroll
    for (int c = 0; c < 64; ++c) { const float d = y[c] - mu; var += d * d; }
    var *= (1.f / 64.f);
    const float rstd = rsqrtf(var + 64e-5f);
    const float bon = ((const float*)(p.ws + OFF_BONUS))[(size_t)m * 6 + h];
    const unsigned char* v4 = p.ws + OFF_V4 + ((size_t)((m >> 2) * 6 + h) * 64) * 8 + (m & 3) * 2;
    u16* gp = (u16*)rowb + C_G + h * 64;
    const float* lg = p.rw_ln_g + l * 384 + h * 64;
    const float* lb = p.rw_ln_b + l * 384 + h * 64;
#pragma unroll
    for (int q = 0; q < 8; ++q) {
      const uint4 gv = *(const uint4*)(gp + q * 8);
      const unsigned gw[4] = {gv.x, gv.y, gv.z, gv.w};
      unsigned o[4];
#pragma unroll
      for (int e = 0; e < 4; ++e) {
        const int c0 = q * 8 + e * 2;
        const float ga = bf2f((u16)(gw[e] & 0xffff)), gb = bf2f((u16)(gw[e] >> 16));
        const float va = (float)(*(const _Float16*)(v4 + (size_t)c0 * 8));
        const float vb = (float)(*(const _Float16*)(v4 + (size_t)(c0 + 1) * 8));
        const float oa = ((y[c0] - mu) * rstd * lg[c0] + lb[c0] + bon * va) * silu_f(ga);
        const float ob = ((y[c0 + 1] - mu) * rstd * lg[c0 + 1] + lb[c0 + 1] + bon * vb) * silu_f(gb);
        o[e] = pack2bf(oa, ob);
      }
      *(uint4*)(gp + q * 8) = uint4{o[0], o[1], o[2], o[3]};
    }
  }
}

DEVI void final_phase(const Params& p) {
  const int tid = TIDX;
  const int lane = tid & 63;
  const int gw = BIDX * 4 + (tid >> 6), nw = gridDim.x * 4;
  for (int m = gw; m < ML; m += nw) {
    float* row = p.out + (size_t)m * 1024;
    float4 v[4];
    float ss = 0.f;
#pragma unroll
    for (int i = 0; i < 4; ++i) {
      v[i] = *(const float4*)(row + i * 256 + lane * 4);
      ss += v[i].x * v[i].x + v[i].y * v[i].y + v[i].z * v[i].z + v[i].w * v[i].w;
    }
#pragma unroll
    for (int o = 32; o > 0; o >>= 1) ss += __shfl_xor(ss, o);
    const float inv = rsqrtf(ss * (1.f / 1024.f) + 1e-6f);
#pragma unroll
    for (int i = 0; i < 4; ++i) {
      const int c0 = i * 256 + lane * 4;
      const float4 g4 = *(const float4*)(p.final_g + c0);
      float4 o;
      o.x = v[i].x * inv * g4.x; o.y = v[i].y * inv * g4.y; o.z = v[i].z * inv * g4.z; o.w = v[i].w * inv * g4.w;
      *(float4*)(row + c0) = o;
    }
  }
}

__global__ void __launch_bounds__(256, 2) mk_kernel(Params p) {
  __shared__ __attribute__((aligned(16))) unsigned char smem[36864];
  cg::grid_group grid = cg::this_grid();
  prologue_phase(p, smem);
  grid.sync();
#pragma unroll 1
  for (int l = 0; l < 4; ++l) {
    norm_phase(p, l);
    grid.sync();
    gemm_phase<0>(p, l, smem);
    grid.sync();
    prep_phase(p, l, smem);
    grid.sync();
    mix_phase(p, l);
    grid.sync();
    post_phase(p, l);
    grid.sync();
    gemm_phase<1>(p, l, smem);
    grid.sync();
  }
  final_phase(p);
}

extern "C" void kernel_launch(void* const* d_in, const int* in_sizes, int n_in, void* d_out, int out_size,
                              void* d_ws, size_t ws_size, hipStream_t stream) {
  static int grid_blocks = 0;
  if (!grid_blocks) {
    int dev = 0, cus = 0, per_cu = 0;
    (void)hipGetDevice(&dev);
    (void)hipDeviceGetAttribute(&cus, hipDeviceAttributeMultiprocessorCount, dev);
    (void)hipOccupancyMaxActiveBlocksPerMultiprocessor(&per_cu, mk_kernel, 256, 0);
    if (per_cu > 2) per_cu = 2;
    if (per_cu < 1) per_cu = 1;
    grid_blocks = cus * per_cu;
  }
  Params p{};
  const float** pp = (const float**)&p;
  for (int i = 0; i < 21; ++i) pp[i] = (const float*)d_in[i];
  p.out = (float*)d_out;
  p.ws = (unsigned char*)d_ws;
  void* args[] = {&p};
  hipError_t e = hipLaunchCooperativeKernel((void*)mk_kernel, dim3(grid_blocks), dim3(256), args, 0, stream);
  if (e != hipSuccess) fprintf(stderr, "coop launch failed: %s (grid %d)\n", hipGetErrorString(e), grid_blocks);
}
```

```cpp
#include <hip/hip_runtime.h>
#include <hip/hip_bf16.h>
#include <hip/hip_cooperative_groups.h>
#include <cstdio>
namespace cg = cooperative_groups;

typedef unsigned short u16;
typedef __attribute__((ext_vector_type(8))) short bf16x8;
typedef __attribute__((ext_vector_type(4))) float f32x4;
typedef _Float16 h8 __attribute__((ext_vector_type(8)));
typedef _Float16 h4 __attribute__((ext_vector_type(4)));

#define DEVI __device__ __forceinline__

constexpr int PW = 3328;
constexpr size_t PROWB = 6656;
constexpr int MT = 16896;
constexpr int ML = 16384;
constexpr int C_R = 0, C_K = 384, C_G = 768, C_WD = 1152, C_AD = 1280, C_Q = 1408, C_KX = 1792,
              C_GA = 1920, C_BG = 2304, C_CG = 2560, C_XIN = 2816, C_GCV = 3072;
constexpr size_t OFF_P = 0;
constexpr size_t OFF_DI = 112459776;
constexpr size_t SZ_DI = 25952256;
constexpr size_t OFF_DD = OFF_DI + SZ_DI;
constexpr size_t SZ_DD1 = 38928384;
constexpr size_t OFF_V4 = OFF_DD + 2 * SZ_DD1;
constexpr size_t OFF_H = OFF_DI;
constexpr size_t OFF_WINT = OFF_DI + 116785152;
constexpr size_t OFF_WOUTT = OFF_WINT + 7864320;
constexpr size_t OFF_LORA = OFF_WOUTT + 2097152;
constexpr size_t OFF_MOD = OFF_LORA + 786432;
constexpr size_t OFF_XC = OFF_MOD + 147456;
constexpr size_t OFF_ROPE = OFF_XC + 2097152;
constexpr size_t OFF_VT = OFF_ROPE + 16384;
constexpr size_t OFF_VTC = OFF_VT + 4194304;
constexpr size_t OFF_BONUS = OFF_VTC + 131072;
constexpr size_t OFF_BAR = OFF_BONUS + 405504;
constexpr size_t OFF_DUMP = OFF_BAR + 16384;

constexpr int SCAN_BLOCKS = 192;

struct Params {
  const float *x, *c, *ctx, *c_ctx, *w_ada, *b_ada, *norm_g, *w_in, *w_out, *rw_w0, *rw_w_up, *rw_a0,
      *rw_a_up, *rw_k_k, *rw_k_a, *rw_r_k, *rw_ln_g, *rw_ln_b, *at_sink, *cv_w, *final_g;
  float* out;
  unsigned char* ws;
};

typedef __bf16 bf2_t __attribute__((ext_vector_type(2)));
typedef float f2_t __attribute__((ext_vector_type(2)));
DEVI unsigned pack2bf(float a, float b) {
  f2_t v = {a, b};
  return __builtin_bit_cast(unsigned, __builtin_convertvector(v, bf2_t));
}
DEVI u16 f2bf(float f) { return (u16)(pack2bf(f, 0.f) & 0xffffu); }
DEVI float bf2f(u16 h) { return __uint_as_float(((unsigned)h) << 16); }
DEVI float sigmoid_f(float x) { return 1.f / (1.f + __expf(-x)); }
DEVI float silu_f(float x) { return x / (1.f + __expf(-x)); }
DEVI float tanh_f(float x) { return 1.f - 2.f / (1.f + __expf(2.f * x)); }
DEVI f32x4 mfma16(bf16x8 a, bf16x8 b, f32x4 c) { return __builtin_amdgcn_mfma_f32_16x16x32_bf16(a, b, c, 0, 0, 0); }

DEVI int opaque_v(int x) { asm volatile("" : "+v"(x)); return x; }
DEVI int opaque_s(int x) { asm volatile("" : "+s"(x)); return x; }
#define TIDX opaque_v((int)threadIdx.x)
#define BIDX opaque_s((int)blockIdx.x)

template <int CTRL>
DEVI float dppf(float x) {
  return __int_as_float(__builtin_amdgcn_update_dpp(0, __float_as_int(x), CTRL, 0xF, 0xF, true));
}
DEVI float reduce32(float x) {
  x += dppf<0xB1>(x);
  x += dppf<0x4E>(x);
  x += dppf<0x141>(x);
  x += dppf<0x140>(x);
  auto r = __builtin_amdgcn_permlane16_swap(__float_as_uint(x), __float_as_uint(x), false, false);
  return __uint_as_float(r[0]) + __uint_as_float(r[1]);
}
template <int HS> DEVI float mixA(unsigned h, float b) {
  float d;
  if (HS) asm("v_fma_mix_f32 %0, %1, %2, 0 op_sel:[1,0,0] op_sel_hi:[1,0,0]" : "=v"(d) : "v"(h), "v"(b));
  else asm("v_fma_mix_f32 %0, %1, %2, 0 op_sel:[0,0,0] op_sel_hi:[1,0,0]" : "=v"(d) : "v"(h), "v"(b));
  return d;
}
template <int HS> DEVI float mixB(unsigned h, float b, float c) {
  float d;
  if (HS) asm("v_fma_mix_f32 %0, %1, %2, %3 op_sel:[1,0,0] op_sel_hi:[1,0,0]" : "=v"(d) : "v"(h), "v"(b), "v"(c));
  else asm("v_fma_mix_f32 %0, %1, %2, %3 op_sel:[0,0,0] op_sel_hi:[1,0,0]" : "=v"(d) : "v"(h), "v"(b), "v"(c));
  return d;
}
template <int HS> DEVI float mixBn(unsigned h, float b, float c) {
  float d;
  if (HS) asm("v_fma_mix_f32 %0, %1, %2, %3 op_sel:[1,0,0] op_sel_hi:[1,0,0]\n\ts_nop 1" : "=v"(d) : "v"(h), "v"(b), "v"(c));
  else asm("v_fma_mix_f32 %0, %1, %2, %3 op_sel:[0,0,0] op_sel_hi:[1,0,0]\n\ts_nop 1" : "=v"(d) : "v"(h), "v"(b), "v"(c));
  return d;
}
template <int HS> DEVI float mixC(unsigned h, float b, float c) {
  float d;
  if (HS) asm("v_fma_mix_f32 %0, -%1, %2, %3 op_sel:[1,0,0] op_sel_hi:[1,0,0]" : "=v"(d) : "v"(h), "v"(b), "v"(c));
  else asm("v_fma_mix_f32 %0, -%1, %2, %3 op_sel:[0,0,0] op_sel_hi:[1,0,0]" : "=v"(d) : "v"(h), "v"(b), "v"(c));
  return d;
}
template <int HS> DEVI float mixD(unsigned h1, unsigned h2, float c) {
  float d;
  if (HS) asm("v_fma_mix_f32 %0, %1, %2, %3 op_sel:[1,1,0] op_sel_hi:[1,1,0]" : "=v"(d) : "v"(h1), "v"(h2), "v"(c));
  else asm("v_fma_mix_f32 %0, %1, %2, %3 op_sel:[0,0,0] op_sel_hi:[1,1,0]" : "=v"(d) : "v"(h1), "v"(h2), "v"(c));
  return d;
}
DEVI float reduce16(float x) {
  x += dppf<0xB1>(x);
  x += dppf<0x4E>(x);
  x += dppf<0x141>(x);
  x += dppf<0x140>(x);
  return x;
}

template <int HS> DEVI float mixAn(unsigned h, float b) {
  float d;
  if (HS) asm("v_fma_mix_f32 %0, %1, %2, 0 op_sel:[1,0,0] op_sel_hi:[1,0,0]\n\ts_nop 1" : "=v"(d) : "v"(h), "v"(b));
  else asm("v_fma_mix_f32 %0, %1, %2, 0 op_sel:[0,0,0] op_sel_hi:[1,0,0]\n\ts_nop 1" : "=v"(d) : "v"(h), "v"(b));
  return d;
}
template <int HS> DEVI float mixBs(unsigned h, float bs, float c) {
  float d;
  if (HS) asm("v_fma_mix_f32 %0, %1, %2, %3 op_sel:[1,0,0] op_sel_hi:[1,0,0]" : "=v"(d) : "v"(h), "s"(bs), "v"(c));
  else asm("v_fma_mix_f32 %0, %1, %2, %3 op_sel:[0,0,0] op_sel_hi:[1,0,0]" : "=v"(d) : "v"(h), "s"(bs), "v"(c));
  return d;
}
template <int CTRL, int RM>
DEVI float dppf_rm(float x) {
  return __int_as_float(__builtin_amdgcn_update_dpp(0, __float_as_int(x), CTRL, RM, 0xF, false));
}
DEVI float reduce64_hi(float x) {
  x += dppf<0xB1>(x);
  x += dppf<0x4E>(x);
  x += dppf<0x141>(x);
  x += dppf<0x140>(x);
  x += dppf_rm<0x142, 0xA>(x);
  x += dppf_rm<0x143, 0xC>(x);
  return x;
}

DEVI float wave_sum(float x) {
  x = reduce64_hi(x);
  return __int_as_float(__builtin_amdgcn_readlane(__float_as_int(x), 63));
}

#define XB_TMO      128
#define XB_XCNT(j)  (256  + 64 * (j))
#define XB_XSUB(j)  (1280 + 64 * (j))
#define XB_XGEN(j)  (2304 + 64 * (j))
#define XB_TOP      3328
#define XB_TOPGEN   3392
#define XCD_BAR_WORDS 3456
#define XB_SPIN_CAP (1u << 22)
#define LAS __attribute__((address_space(3)))
DEVI unsigned xb_ld(unsigned* p) { return __hip_atomic_load(p, __ATOMIC_RELAXED, __HIP_MEMORY_SCOPE_AGENT); }
DEVI unsigned xb_add(unsigned* p, unsigned v) { return __hip_atomic_fetch_add(p, v, __ATOMIC_RELAXED, __HIP_MEMORY_SCOPE_AGENT); }
DEVI unsigned xb_xcc_id() { return (unsigned)__builtin_amdgcn_s_getreg((3 << 11) | 20) & 0xFu; }
#define XB_SPIN(cond, bar) do { unsigned _sp = 0; while (cond) { __builtin_amdgcn_s_sleep(1); \
    if ((++_sp & 255u) == 0u) { if (xb_ld(&(bar)[XB_TMO])) break; if (_sp > XB_SPIN_CAP) { atomicAdd(&(bar)[XB_TMO], 1u); break; } } } } while (0)
struct XcdBarrier { unsigned* bar; unsigned x; volatile LAS unsigned* st; };
DEVI XcdBarrier xcd_barrier_post(unsigned* bar, volatile LAS unsigned* st) {
  XcdBarrier b; b.bar = bar; b.x = xb_xcc_id(); b.st = st;
  if (threadIdx.x == 0) (void)xb_add(&bar[XB_XCNT(b.x)], 1u);
  return b;
}
DEVI void xcd_barrier_complete(unsigned* bar, unsigned x, unsigned& nloc, unsigned& nx) {
  const unsigned G = gridDim.x * gridDim.y * gridDim.z;
  unsigned sum, cnt, mine, sp = 0u;
  for (;;) {
    sum = 0u; cnt = 0u; mine = 0u;
#pragma unroll
    for (unsigned j = 0; j < 16; ++j) { const unsigned c = xb_ld(&bar[XB_XCNT(j)]); sum += c; cnt += (c > 0u) ? 1u : 0u; mine = (j == x) ? c : mine; }
    if (sum == G) break;
    __builtin_amdgcn_s_sleep(1);
    if ((++sp & 255u) == 0u) { if (xb_ld(&bar[XB_TMO])) break; if (sp > XB_SPIN_CAP) { atomicAdd(&bar[XB_TMO], 1u); break; } }
  }
  nloc = mine > 0u ? mine : 1u; nx = cnt > 0u ? cnt : 1u;
}
DEVI void xcd_barrier(const XcdBarrier& b) {
  asm volatile("s_waitcnt vmcnt(0)" ::: "memory");
  __syncthreads();
  if (threadIdx.x == 0) {
    unsigned* bar = b.bar;
    __builtin_amdgcn_s_waitcnt(0);
    unsigned nloc = b.st[0], nx = b.st[1];
    if (nloc == 0u) { xcd_barrier_complete(bar, b.x, nloc, nx); b.st[0] = nloc; b.st[1] = nx; }
    const unsigned old = xb_add(&bar[XB_XSUB(b.x)], 1u);
    const unsigned gen = old / nloc;
    if (old + 1u == (gen + 1u) * nloc) {
      __builtin_amdgcn_fence(__ATOMIC_RELEASE, "agent");
      asm volatile("s_waitcnt vmcnt(0)" ::: "memory");
      const unsigned og = xb_add(&bar[XB_TOP], 1u);
      const unsigned tg = og / nx;
      if (og + 1u == (tg + 1u) * nx) xb_add(&bar[XB_TOPGEN], 1u);
      else XB_SPIN(xb_ld(&bar[XB_TOPGEN]) == tg, bar);
      __builtin_amdgcn_fence(__ATOMIC_ACQUIRE, "agent");
      xb_add(&bar[XB_XGEN(b.x)], 1u);
      asm volatile("s_waitcnt vmcnt(0)" ::: "memory");
    } else {
      XB_SPIN(xb_ld(&bar[XB_XGEN(b.x)]) == gen, bar);
      __builtin_amdgcn_fence(__ATOMIC_ACQUIRE, "agent");
      asm volatile("s_waitcnt vmcnt(0)" ::: "memory");
    }
  }
  __syncthreads();
}

DEVI void transpose_tile(const float* __restrict__ src, int N, int K, int k0, int n0, u16* __restrict__ dst,
                         float* tile) {
  const int tid = TIDX;
  for (int e = tid; e < 4096; e += 256) {
    int r = e >> 6, cc = e & 63;
    tile[r * 65 + cc] = src[(size_t)(k0 + r) * N + n0 + cc];
  }
  __syncthreads();
  for (int e = tid; e < 4096; e += 256) {
    int n = e >> 6, k = e & 63;
    dst[(size_t)(n0 + n) * K + k0 + k] = f2bf(tile[k * 65 + n]);
  }
  __syncthreads();
}
DEVI void convert_weight(const float* src, int K, int N, u16* dst, float* tile, int t0, int stride) {
  const int nk = K >> 6, nn = N >> 6;
  for (int t = t0; t < nk * nn; t += stride) transpose_tile(src, N, K, (t % nk) * 64, (t / nk) * 64, dst, tile);
}

DEVI void mod_task(const Params& p, int task, float* sm) {
  const int l = task / 48, n0 = (task % 48) * 64;
  const int tid = TIDX;
  for (int e = tid; e < 3072; e += 256) {
    int bi = e >> 10, k = e & 1023;
    float v = bi < 2 ? p.c[bi * 1024 + k] : p.c_ctx[k];
    sm[e] = silu_f(v);
  }
  __syncthreads();
  const int c4 = tid & 15, kg = tid >> 4;
  const float* w = p.w_ada + (size_t)l * 1024 * 3072 + n0 + c4 * 4;
  float4 a0 = float4{0.f, 0.f, 0.f, 0.f}, a1 = a0, a2 = a0;
#pragma unroll 16
  for (int k = kg * 64; k < kg * 64 + 64; ++k) {
    const float4 wv = *(const float4*)(w + (size_t)k * 3072);
    const float s0 = sm[k], s1 = sm[1024 + k], s2 = sm[2048 + k];
    a0.x += s0 * wv.x; a0.y += s0 * wv.y; a0.z += s0 * wv.z; a0.w += s0 * wv.w;
    a1.x += s1 * wv.x; a1.y += s1 * wv.y; a1.z += s1 * wv.z; a1.w += s1 * wv.w;
    a2.x += s2 * wv.x; a2.y += s2 * wv.y; a2.z += s2 * wv.z; a2.w += s2 * wv.w;
  }
  float* red = sm + 3072;
  *(float4*)(red + (kg * 3 + 0) * 64 + c4 * 4) = a0;
  *(float4*)(red + (kg * 3 + 1) * 64 + c4 * 4) = a1;
  *(float4*)(red + (kg * 3 + 2) * 64 + c4 * 4) = a2;
  __syncthreads();
  if (tid < 192) {
    int bi = tid >> 6, cc = tid & 63;
    float s = p.b_ada[l * 3072 + n0 + cc];
    for (int q = 0; q < 16; ++q) s += red[(q * 3 + bi) * 64 + cc];
    float* mod = (float*)(p.ws + OFF_MOD);
    mod[(l * 3 + bi) * 3072 + n0 + cc] = s;
  }
  __syncthreads();
}

DEVI void prologue_phase(const Params& p, unsigned char* smem) {
  float* tile = (float*)smem;
  const int bid = BIDX;
  convert_weight(p.w_in, 1024, 3840, (u16*)(p.ws + OFF_WINT), tile, bid, gridDim.x);
  for (int t = bid; t < 96; t += gridDim.x) {
    int ct = t % 6, mat = t / 6;
    int kind = mat & 1, ld = mat >> 1;
    const float* src = (kind ? p.rw_a_up : p.rw_w_up) + (size_t)ld * 64 * 384;
    transpose_tile(src, 384, 64, 0, ct * 64, (u16*)(p.ws + OFF_LORA) + (size_t)mat * 384 * 64, tile);
  }
  for (int t = bid; t < 192; t += gridDim.x) mod_task(p, t, tile);
  if (bid == (int)gridDim.x - 1) {
    float* rope = (float*)(p.ws + OFF_ROPE);
    for (int e = TIDX; e < 2048; e += 256) {
      int pos = e >> 4, f = e & 15;
      float inv = exp2f(-(float)f * (13.287712379549449f / 16.f));
      float ang = (float)pos * inv;
      rope[e * 2] = cosf(ang);
      rope[e * 2 + 1] = sinf(ang);
    }
  }
}

DEVI void norm_phase(const Params& p, int l) {
  const int tid = TIDX;
  const int lane = tid & 63;
  const int gw = BIDX * 4 + (tid >> 6), nw = gridDim.x * 4;
  const float* xs = l == 0 ? p.x : p.out;
  const float* xcs = l == 0 ? p.ctx : (const float*)(p.ws + OFF_XC);
  const float* mod = (const float*)(p.ws + OFF_MOD) + (size_t)l * 3 * 3072;
  const float* ng = p.norm_g + l * 1024;
  u16* H = (u16*)(p.ws + OFF_H);
  for (int m = gw; m < MT; m += nw) {
    const float* row = m < ML ? xs + (size_t)m * 1024 : xcs + (size_t)(m - ML) * 1024;
    const int bi = m < 8192 ? 0 : (m < ML ? 1 : 2);
    float4 v[4];
    float ss = 0.f;
#pragma unroll
    for (int i = 0; i < 4; ++i) {
      v[i] = *(const float4*)(row + i * 256 + lane * 4);
      ss += v[i].x * v[i].x + v[i].y * v[i].y + v[i].z * v[i].z + v[i].w * v[i].w;
    }
    ss = wave_sum(ss);
    const float inv = rsqrtf(ss * (1.f / 1024.f) + 1e-6f);
    const float* md = mod + bi * 3072;
#pragma unroll
    for (int i = 0; i < 4; ++i) {
      const int c0 = i * 256 + lane * 4;
      float4 g4 = *(const float4*)(ng + c0);
      float4 sh = *(const float4*)(md + c0);
      float4 sc = *(const float4*)(md + 1024 + c0);
      float o0 = v[i].x * inv * g4.x * (1.f + sc.x) + sh.x;
      float o1 = v[i].y * inv * g4.y * (1.f + sc.y) + sh.y;
      float o2 = v[i].z * inv * g4.z * (1.f + sc.z) + sh.z;
      float o3 = v[i].w * inv * g4.w * (1.f + sc.w) + sh.w;
      uint2 pk;
      pk.x = pack2bf(o0, o1);
      pk.y = pack2bf(o2, o3);
      *(uint2*)(H + (size_t)m * 1024 + c0) = pk;
    }
  }
}

template <int MODE>
DEVI void gemm_phase(const Params& p, int l, unsigned char* smem, int tb0, int tbs) {
  constexpr int KT0 = MODE == 2 ? 6 : 0;
  constexpr int NKT = MODE == 0 ? 16 : (MODE == 1 ? 6 : 10);
  u16* sA = (u16*)smem;
  u16* sB = sA + 128 * 64;
  const int tid = TIDX, lane = tid & 63, wave = tid >> 6, wm = wave >> 1, wn = wave & 1;
  const int fr = lane & 15, g = lane >> 4;
  const int ntn = MODE == 0 ? 30 : 8;
  const int ntm = MODE == 0 ? 132 : (l < 3 ? 132 : 128);
  const bool TRfix = MODE != 0;
  const u16* A = MODE == 0 ? (const u16*)(p.ws + OFF_H) : (const u16*)(p.ws + OFF_P);
  const int lda = MODE == 0 ? 1024 : PW;
  const u16* Bt = MODE == 0 ? (const u16*)(p.ws + OFF_WINT) : (const u16*)(p.ws + OFF_WOUTT);
  u16* P = (u16*)(p.ws + OFF_P);

  const int ntiles = ntm * ntn;
#define TILE_OF(t0v) ((MODE != 2 && tbs == 512) ? (((t0v) & ~511) + (((t0v) & 7) << 6) + (((t0v) & 511) >> 3)) : (t0v))
  const int lrow = tid >> 3, lseg = tid & 7;
  const int soff = lrow * 64 + ((lseg ^ ((lrow >> 1) & 7)) << 3);
  uint4 xa0, xa1, xa2, xa3, xb0, xb1, xb2, xb3;
  uint4 ya0, ya1, ya2, ya3, yb0, yb1, yb2, yb3;
  const u16* aptr;
  const u16* bptr;
#define ACOL(kt) (MODE == 0 ? (kt) * 64 : ((kt) < 6 ? C_G + (kt) * 64 : ((kt) < 12 ? C_GA + ((kt) - 6) * 64 : C_BG + ((kt) - 12) * 64)))
#define GLOAD(P, kt)                                                           \
  {                                                                            \
    const int acol_ = ACOL(kt);                                                \
    P##a0 = *(const uint4*)(aptr + acol_);                                     \
    P##a1 = *(const uint4*)(aptr + (size_t)32 * lda + acol_);                  \
    P##a2 = *(const uint4*)(aptr + (size_t)64 * lda + acol_);                  \
    P##a3 = *(const uint4*)(aptr + (size_t)96 * lda + acol_);                  \
    P##b0 = *(const uint4*)(bptr + (kt) * 64);                                 \
    P##b1 = *(const uint4*)(bptr + 32 * 1024 + (kt) * 64);                     \
    P##b2 = *(const uint4*)(bptr + 64 * 1024 + (kt) * 64);                     \
    P##b3 = *(const uint4*)(bptr + 96 * 1024 + (kt) * 64);                     \
  }
#define SSTORE(P, buf)                                                         \
  {                                                                            \
    u16* sa_ = sA + (buf) * 16384 + soff;                                      \
    u16* sb_ = sa_ + 128 * 64;                                                 \
    *(uint4*)(sa_) = P##a0;                                                    \
    *(uint4*)(sa_ + 32 * 64) = P##a1;                                          \
    *(uint4*)(sa_ + 64 * 64) = P##a2;                                          \
    *(uint4*)(sa_ + 96 * 64) = P##a3;                                          \
    *(uint4*)(sb_) = P##b0;                                                    \
    *(uint4*)(sb_ + 32 * 64) = P##b1;                                          \
    *(uint4*)(sb_ + 64 * 64) = P##b2;                                          \
    *(uint4*)(sb_ + 96 * 64) = P##b3;                                          \
  }
#define COMPUTE(buf)                                                           \
  {                                                                            \
    const u16* c1_ = s1 + (buf) * 16384;                                       \
    const u16* c2_ = s2 + (buf) * 16384;                                       \
    _Pragma("unroll") for (int s = 0; s < 2; ++s) {                            \
      bf16x8 f1[4], f2[4];                                                     \
      const int sw_ = ((4 * s + g) ^ (fr >> 1)) << 3;                          \
      _Pragma("unroll") for (int i = 0; i < 4; ++i) {                          \
        f1[i] = *(const bf16x8*)(c1_ + (w1 + i * 16 + fr) * 64 + sw_);         \
        f2[i] = *(const bf16x8*)(c2_ + (w2 + i * 16 + fr) * 64 + sw_);         \
      }                                                                        \
      _Pragma("unroll") for (int i = 0; i < 4; ++i)                            \
        _Pragma("unroll") for (int j = 0; j < 4; ++j) acc[i][j] = mfma16(f1[i], f2[j], acc[i][j]); \
    }                                                                          \
  }
  int t0 = tb0;
  int t = TILE_OF(t0);
  bool have = t < ntiles;
  if (have) {
    aptr = A + (size_t)((t / ntn) * 128 + lrow) * lda + lseg * 8;
    bptr = Bt + (size_t)((t % ntn) * 128 + lrow) * 1024 + lseg * 8;
    GLOAD(x, KT0);
    GLOAD(y, KT0 + 1);
  }
  while (have) {
    const int tn = t % ntn, tm = t / ntn;
    const int m0 = tm * 128, n0 = tn * 128;
    bool TR = TRfix;
    if (MODE == 0) TR = !((tn >= 6 && tn < 9) || tn == 18);
    const u16* s1 = TR ? sB : sA;
    const u16* s2 = TR ? sA : sB;
    const int w1 = (TR ? wn : wm) * 64, w2 = (TR ? wm : wn) * 64;

    f32x4 acc[4][4];
#pragma unroll
    for (int i = 0; i < 4; ++i)
#pragma unroll
      for (int j = 0; j < 4; ++j) acc[i][j] = f32x4{0.f, 0.f, 0.f, 0.f};

    __syncthreads();
    SSTORE(x, 0);
    GLOAD(x, KT0 + 2);
    __syncthreads();
#pragma unroll 1
    for (int kt = 0; kt < NKT; kt += 2) {
      SSTORE(y, 1);
      if (kt + 3 < NKT) GLOAD(y, KT0 + kt + 3);
      COMPUTE(0);
      __syncthreads();
      if (kt + 2 < NKT) SSTORE(x, 0);
      if (kt + 4 < NKT) GLOAD(x, KT0 + kt + 4);
      COMPUTE(1);
      __syncthreads();
    }
    t0 += tbs;
    const int tnext = TILE_OF(t0);
    const bool havenext = tnext < ntiles;
    if (havenext) {
      aptr = A + (size_t)((tnext / ntn) * 128 + lrow) * lda + lseg * 8;
      bptr = Bt + (size_t)((tnext % ntn) * 128 + lrow) * 1024 + lseg * 8;
      GLOAD(x, KT0);
      GLOAD(y, KT0 + 1);
    }

    if (MODE != 0) {
      const float* mod = (const float*)(p.ws + OFF_MOD) + (size_t)l * 3 * 3072;
#pragma unroll
      for (int b2 = 0; b2 < 4; ++b2) {
        const int m = m0 + wm * 64 + b2 * 16 + fr;
        const int bi = m < 8192 ? 0 : (m < ML ? 1 : 2);
        const float* src;
        float* dst;
        if (m < ML) {
          src = ((MODE == 2 && l == 0) ? p.x : p.out) + (size_t)m * 1024;
          dst = p.out + (size_t)m * 1024;
        } else {
          src = ((MODE == 2 && l == 0) ? p.ctx : (const float*)(p.ws + OFF_XC)) + (size_t)(m - ML) * 1024;
          dst = (float*)(p.ws + OFF_XC) + (size_t)(m - ML) * 1024;
        }
#pragma unroll
        for (int a = 0; a < 4; ++a) {
          const int n = n0 + wn * 64 + a * 16 + 4 * g;
          float4 xo = *(const float4*)(src + n);
          float4 gt = *(const float4*)(mod + bi * 3072 + 2048 + n);
          float4 o;
          o.x = xo.x + gt.x * acc[a][b2][0];
          o.y = xo.y + gt.y * acc[a][b2][1];
          o.z = xo.z + gt.z * acc[a][b2][2];
          o.w = xo.w + gt.w * acc[a][b2][3];
          *(float4*)(dst + n) = o;
        }
      }
    } else {
      const int nbase = n0 + wn * 64;
      if (!TR) {
        if (tn == 18) {
#pragma unroll
          for (int mt = 0; mt < 4; ++mt) {
            const int mb = m0 + wm * 64 + mt * 16 + 4 * g;
#pragma unroll
            for (int nt = 0; nt < 4; ++nt) {
              const int hc = nbase - 2304 + nt * 16 + fr;
              const int kvh = hc >> 6, d = hc & 63;
              uint2 pk;
              pk.x = pack2bf(acc[mt][nt][0], acc[mt][nt][1]);
              pk.y = pack2bf(acc[mt][nt][2], acc[mt][nt][3]);
              if (mb < ML) {
                const int b = mb >> 13, tk = mb & 8191;
                u16* dst = (u16*)(p.ws + OFF_VT) + ((size_t)((b * 2 + kvh) * 64 + d)) * 8192 + tk;
                *(uint2*)dst = pk;
              } else {
                const int mm = mb - ML, b = mm >> 8, tk = mm & 255;
                u16* dst = (u16*)(p.ws + OFF_VTC) + ((size_t)((b * 2 + kvh) * 64 + d)) * 256 + tk;
                *(uint2*)dst = pk;
              }
            }
          }
        } else {
#pragma unroll
          for (int mt = 0; mt < 4; ++mt) {
            const int tg = ((m0 + wm * 64 + mt * 16) >> 2) + g;
#pragma unroll
            for (int nt = 0; nt < 4; ++nt) {
              const int hc = nbase - 768 + nt * 16 + fr;
              const int h = hc >> 6, rv = hc & 63;
              h4 hv;
              hv[0] = (_Float16)acc[mt][nt][0];
              hv[1] = (_Float16)acc[mt][nt][1];
              hv[2] = (_Float16)acc[mt][nt][2];
              hv[3] = (_Float16)acc[mt][nt][3];
              *(h4*)(p.ws + OFF_V4 + ((size_t)(tg * 6 + h) * 64 + rv) * 8) = hv;
            }
          }
        }
      } else {
        const int pc = nbase < 768 ? nbase : (nbase < 2304 ? nbase - 384 : nbase - 512);
        const bool rope = (tn >= 14 && tn < 18);
        const float* ropeT = (const float*)(p.ws + OFF_ROPE);
#pragma unroll
        for (int b2 = 0; b2 < 4; ++b2) {
          const int m = m0 + wm * 64 + b2 * 16 + fr;
          if (rope && m < ML) {
            const int tk = m & 8191;
#pragma unroll
            for (int a = 0; a < 2; ++a) {
              const int pos = a == 0 ? (tk >> 6) : (tk & 63);
#pragma unroll
              for (int i = 0; i < 4; ++i) {
                const int f = 4 * g + i;
                const float cs = ropeT[(pos * 16 + f) * 2], sn = ropeT[(pos * 16 + f) * 2 + 1];
                const float t1 = acc[a][b2][i], t2 = acc[a + 2][b2][i];
                acc[a][b2][i] = t1 * cs - t2 * sn;
                acc[a + 2][b2][i] = t1 * sn + t2 * cs;
              }
            }
          }
          if (tn == 12) {
#pragma unroll
            for (int a = 0; a < 4; ++a)
#pragma unroll
              for (int i = 0; i < 4; ++i) acc[a][b2][i] = tanh_f(acc[a][b2][i]);
          }
#pragma unroll
          for (int a = 0; a < 4; ++a) {
            uint2 pk;
            pk.x = pack2bf(acc[a][b2][0], acc[a][b2][1]);
            pk.y = pack2bf(acc[a][b2][2], acc[a][b2][3]);
            *(uint2*)(sA + (wm * 64 + b2 * 16 + fr) * 136 + wn * 64 + a * 16 + 4 * g) = pk;
          }
        }
        __syncthreads();
        {
          const int pc0 = n0 < 768 ? n0 : (n0 < 2304 ? n0 - 384 : n0 - 512);
#pragma unroll
          for (int q = 0; q < 8; ++q) {
            const int c = tid + 256 * q, row = c >> 4, ch = c & 15;
            const uint4 v = *(const uint4*)(sA + row * 136 + ch * 8);
            *(uint4*)(P + (size_t)(m0 + row) * PW + pc0 + ch * 8) = v;
          }
        }
      }
    }
    t = tnext;
    have = havenext;
  }
#undef GLOAD
#undef SSTORE
#undef COMPUTE
#undef ACOL
#undef TILE_OF
}

DEVI void prep_wave_task(const Params& p, int l, int m0, int h, int lane) {
  const int fr = lane & 15, g = lane >> 4;
  const u16* P = (const u16*)(p.ws + OFF_P);
  const u16* Prow = P + (size_t)(m0 + fr) * PW;
  float kf[4][4], rf[4][4], kkv[4][4];
  float kkp[4], kap[4], rkp[4];
#pragma unroll
  for (int nt = 0; nt < 4; ++nt) {
    const int c = h * 64 + nt * 16 + fr;
    kkp[nt] = p.rw_k_k[l * 384 + c];
    kap[nt] = p.rw_k_a[l * 384 + c];
    rkp[nt] = p.rw_r_k[l * 384 + c];
  }
  float ss[4], bs[4];
#pragma unroll
  for (int i = 0; i < 4; ++i) {
    const u16* q = P + (size_t)(m0 + 4 * g + i) * PW;
    ss[i] = 0.f;
    bs[i] = 0.f;
#pragma unroll
    for (int nt = 0; nt < 4; ++nt) {
      const int c = h * 64 + nt * 16 + fr;
      kf[i][nt] = bf2f(q[C_K + c]);
      rf[i][nt] = bf2f(q[C_R + c]);
      const float kr = kf[i][nt] * kkp[nt];
      kkv[i][nt] = kr;
      ss[i] += kr * kr;
      bs[i] += rf[i][nt] * kf[i][nt] * rkp[nt];
    }
    ss[i] = reduce16(ss[i]);
    bs[i] = reduce16(bs[i]);
    const float rn = rsqrtf(fmaxf(ss[i], 1e-12f));
#pragma unroll
    for (int nt = 0; nt < 4; ++nt) kkv[i][nt] *= rn;
    if (fr == 0) ((float*)(p.ws + OFF_BONUS))[(size_t)(m0 + 4 * g + i) * 6 + h] = bs[i];
  }
  const int tg = (m0 >> 2) + g;
#pragma unroll
  for (int nt = 0; nt < 4; ++nt) {
    const int c = nt * 16 + fr;
    unsigned char* base = p.ws + OFF_DI + ((size_t)(tg * 6 + h) * 64 + c) * 16;
    h4 a, b;
#pragma unroll
    for (int i = 0; i < 4; ++i) {
      a[i] = (_Float16)kkv[i][nt];
      b[i] = (_Float16)rf[i][nt];
    }
    *(h4*)base = a;
    *(h4*)(base + 8) = b;
  }
  const u16* LT = (const u16*)(p.ws + OFF_LORA);
#pragma unroll 1
  for (int d = 0; d < 2; ++d) {
    f32x4 accw[4], acca[4];
#pragma unroll
    for (int nt = 0; nt < 4; ++nt) {
      accw[nt] = f32x4{0.f, 0.f, 0.f, 0.f};
      acca[nt] = f32x4{0.f, 0.f, 0.f, 0.f};
    }
#pragma unroll
    for (int s = 0; s < 2; ++s) {
      const bf16x8 aw = *(const bf16x8*)(Prow + C_WD + d * 64 + s * 32 + g * 8);
      const bf16x8 aa = *(const bf16x8*)(Prow + C_AD + d * 64 + s * 32 + g * 8);
#pragma unroll
      for (int nt = 0; nt < 4; ++nt) {
        const size_t rw = (size_t)(h * 64 + nt * 16 + fr) * 64 + s * 32 + g * 8;
        const bf16x8 bw = *(const bf16x8*)(LT + (size_t)((l * 2 + d) * 2 + 0) * 384 * 64 + rw);
        const bf16x8 ba = *(const bf16x8*)(LT + (size_t)((l * 2 + d) * 2 + 1) * 384 * 64 + rw);
        accw[nt] = mfma16(aw, bw, accw[nt]);
        acca[nt] = mfma16(aa, ba, acca[nt]);
      }
    }
#pragma unroll
    for (int nt = 0; nt < 4; ++nt) {
      const int cl = nt * 16 + fr, c = h * 64 + cl;
      const float w0 = p.rw_w0[(l * 2 + d) * 384 + c];
      const float a0 = p.rw_a0[(l * 2 + d) * 384 + c];
      h4 hu, hn, hk;
#pragma unroll
      for (int i = 0; i < 4; ++i) {
        const float sig = sigmoid_f(w0 + accw[nt][i]);
        const float u = 1.f - __expf(-0.60653066f * sig);
        const float av = sigmoid_f(a0 + acca[nt][i]);
        hu[i] = (_Float16)u;
        hn[i] = (_Float16)(-kkv[i][nt] * av);
        hk[i] = (_Float16)(kf[i][nt] * (1.f + (av - 1.f) * kap[nt]));
      }
      unsigned char* base = p.ws + OFF_DD + (size_t)d * SZ_DD1 + ((size_t)(tg * 6 + h) * 64 + cl) * 24;
      *(h4*)base = hu;
      *(h4*)(base + 8) = hn;
      *(h4*)(base + 16) = hk;
    }
  }
}

DEVI void prep_phase(const Params& p, int l, unsigned char* smem) {
  const int tid = TIDX, lane = tid & 63;
  const int bid = BIDX;
  u16* P = (u16*)(p.ws + OFF_P);
  const int gw = bid * 4 + (tid >> 6), nw = (int)gridDim.x * 4;
  for (int wt = gw; wt < (MT / 16) * 6; wt += nw) prep_wave_task(p, l, (wt / 6) * 16, wt % 6, lane);
}

DEVI void conv_items(const Params& p, int l, int start, int stride) {
  u16* P = (u16*)(p.ws + OFF_P);
#pragma unroll 1
  for (int item = start; item < MT * 32; item += stride) {
      const int m = item >> 5, ch = (item & 31) * 8;
      int pos, last;
      if (m < ML) { pos = m & 8191; last = 8191; } else { pos = (m - ML) & 255; last = 255; }
      const u16* row = P + (size_t)m * PW;
      float uc[8], up[8], un[8];
      {
        bf16x8 a = *(const bf16x8*)(row + C_CG + ch), b = *(const bf16x8*)(row + C_XIN + ch);
#pragma unroll
        for (int e = 0; e < 8; ++e) uc[e] = bf2f((u16)a[e]) * bf2f((u16)b[e]);
      }
      if (pos > 0) {
        bf16x8 a = *(const bf16x8*)(row - PW + C_CG + ch), b = *(const bf16x8*)(row - PW + C_XIN + ch);
#pragma unroll
        for (int e = 0; e < 8; ++e) up[e] = bf2f((u16)a[e]) * bf2f((u16)b[e]);
      } else {
#pragma unroll
        for (int e = 0; e < 8; ++e) up[e] = 0.f;
      }
      if (pos < last) {
        bf16x8 a = *(const bf16x8*)(row + PW + C_CG + ch), b = *(const bf16x8*)(row + PW + C_XIN + ch);
#pragma unroll
        for (int e = 0; e < 8; ++e) un[e] = bf2f((u16)a[e]) * bf2f((u16)b[e]);
      } else {
#pragma unroll
        for (int e = 0; e < 8; ++e) un[e] = 0.f;
      }
      bf16x8 bg = *(const bf16x8*)(row + C_BG + ch), gc = *(const bf16x8*)(row + C_GCV + ch);
      const float* cw = p.cv_w + l * 768;
      unsigned o[4];
#pragma unroll
      for (int e = 0; e < 8; e += 2) {
        float y0 = up[e] * cw[ch + e] + uc[e] * cw[256 + ch + e] + un[e] * cw[512 + ch + e];
        float y1 = up[e + 1] * cw[ch + e + 1] + uc[e + 1] * cw[256 + ch + e + 1] + un[e + 1] * cw[512 + ch + e + 1];
        y0 = bf2f((u16)bg[e]) * y0 * silu_f(bf2f((u16)gc[e]));
        y1 = bf2f((u16)bg[e + 1]) * y1 * silu_f(bf2f((u16)gc[e + 1]));
        o[e >> 1] = pack2bf(y0, y1);
      }
      *(uint4*)(P + (size_t)m * PW + C_BG + ch) = uint4{o[0], o[1], o[2], o[3]};
  }
}

constexpr int CHUNK_B = 20992;
#define SCAN_RED_HEAD(OS)                                                                                     \
  "v_fma_mix_f32 %[pp], %[kk0], %[S0], 0 op_sel:[" OS ",0,0] op_sel_hi:[1,0,0]\n\t"                           \
  "v_fma_mix_f32 %[pp], %[kk1], %[S1], %[pp] op_sel:[" OS ",0,0] op_sel_hi:[1,0,0]\n\t"                       \
  "v_fma_mix_f32 %[T0], -%[u0], %[S0], %[S0] op_sel:[" OS ",0,0] op_sel_hi:[1,0,0]\n\t"                       \
  "v_fma_mix_f32 %[T1], -%[u1], %[S1], %[S1] op_sel:[" OS ",0,0] op_sel_hi:[1,0,0]\n\t"                       \
  "v_add_f32_dpp %[pp], %[pp], %[pp] quad_perm:[1,0,3,2] row_mask:0xf bank_mask:0xf bound_ctrl:1\n\t"         \
  "v_fma_mix_f32 %[T0], %[vd], %[kd0], %[T0] op_sel:[" OS "," OS ",0] op_sel_hi:[1,1,0]\n\t"                  \
  "v_fma_mix_f32 %[T1], %[vd], %[kd1], %[T1] op_sel:[" OS "," OS ",0] op_sel_hi:[1,1,0]\n\t"                  \
  "v_add_f32_dpp %[pp], %[pp], %[pp] quad_perm:[2,3,0,1] row_mask:0xf bank_mask:0xf bound_ctrl:1\n\t"
#define SCAN_RED_TAIL(OS)                                                                                     \
  "v_add_f32_dpp %[pp], %[pp], %[pp] row_half_mirror row_mask:0xf bank_mask:0xf bound_ctrl:1\n\t"             \
  "s_nop 1\n\t"                                                                                               \
  "v_add_f32_dpp %[pp], %[pp], %[pp] row_mirror row_mask:0xf bank_mask:0xf bound_ctrl:1\n\t"                  \
  "v_mov_b32 %[tmp], %[pp]\n\t"                                                                               \
  "s_nop 1\n\t"                                                                                               \
  "v_permlane16_swap_b32 %[pp], %[tmp]\n\t"                                                                   \
  "v_add_f32 %[pp], %[pp], %[tmp]\n\t"                                                                        \
  "v_fma_mix_f32 %[S0], %[nk0], %[pp], %[T0] op_sel:[" OS ",0,0] op_sel_hi:[1,0,0]\n\t"                       \
  "v_fma_mix_f32 %[S1], %[nk1], %[pp], %[T1] op_sel:[" OS ",0,0] op_sel_hi:[1,0,0]\n\t"
#define SCAN_PY(OS, Y)                                                                                        \
  "v_fma_mix_f32 %[" Y "], %[r0], %[S0], 0 op_sel:[" OS ",0,0] op_sel_hi:[1,0,0]\n\t"                         \
  "v_fma_mix_f32 %[" Y "], %[r1], %[S1], %[" Y "] op_sel:[" OS ",0,0] op_sel_hi:[1,0,0]\n\t"
#define SCAN_PY_LAST(OS, Y)                                                                                   \
  "v_fma_mix_f32 %[" Y "], %[r0], %[S0], 0 op_sel:[" OS ",0,0] op_sel_hi:[1,0,0]\n\t"                         \
  "v_fma_mix_f32 %[" Y "], %[r1], %[S1], %[" Y "] op_sel:[" OS ",0,0] op_sel_hi:[1,0,0]"
#define SCAN_PAIR_ASM(OSA, OSB)                                                                               \
  SCAN_RED_HEAD(OSA) "s_nop 1\n\t" SCAN_RED_TAIL(OSA)                                                         \
  SCAN_RED_HEAD(OSB) SCAN_PY(OSA, "ya") SCAN_RED_TAIL(OSB)                                                    \
  SCAN_PY_LAST(OSB, "yb")
#define DPPQ "row_mask:0xf bank_mask:0xf bound_ctrl:1\n\t"
#define SCAN_TAIL_W(OS, N1, N2)                                                                               \
  "v_add_f32_dpp %[pp], %[pp], %[pp] row_half_mirror " DPPQ N1                                               \
  "v_add_f32_dpp %[pp], %[pp], %[pp] row_mirror " DPPQ                                                       \
  "v_mov_b32 %[tmp], %[pp]\n\t" N2                                                                            \
  "v_permlane16_swap_b32 %[pp], %[tmp]\n\t"                                                                   \
  "v_add_f32 %[pp], %[pp], %[tmp]\n\t"                                                                        \
  "v_fma_mix_f32 %[S0], %[nk0], %[pp], %[T0] op_sel:[" OS ",0,0] op_sel_hi:[1,0,0]\n\t"                       \
  "v_fma_mix_f32 %[S1], %[nk1], %[pp], %[T1] op_sel:[" OS ",0,0] op_sel_hi:[1,0,0]\n\t"
#define R1_2  "v_cndmask_b32_e64 %[t1], %[a1], %[a0], %[m0]\n\t" "v_cndmask_b32_e64 %[t3], %[a3], %[a2], %[m0]\n\t"
#define R3_4  "v_cndmask_b32_e64 %[t0], %[a0], %[a1], %[m0]\n\t" "v_cndmask_b32_e64 %[t2], %[a2], %[a3], %[m0]\n\t"
#define R5_6  "v_add_f32_dpp %[t0], %[t1], %[t0] quad_perm:[1,0,3,2] " DPPQ "v_add_f32_dpp %[t2], %[t3], %[t2] quad_perm:[1,0,3,2] " DPPQ
#define R7_8  "v_cndmask_b32_e64 %[t3], %[t2], %[t0], %[m1]\n\t" "v_cndmask_b32_e64 %[t1], %[t0], %[t2], %[m1]\n\t"
#define R9    "v_add_f32_dpp %[t1], %[t3], %[t1] quad_perm:[2,3,0,1] " DPPQ "s_nop 0\n\t"
#define R10   "v_add_f32_dpp %[t1], %[t1], %[t1] row_ror:4 " DPPQ "s_nop 0\n\t"
#define R11   "v_add_f32_dpp %[t1], %[t1], %[t1] row_ror:8 " DPPQ "s_nop 0\n\t"
#define R12   "v_mov_b32 %[t3], %[t1]\n\t" "s_nop 0\n\t"
#define R13_14 "v_permlane16_swap_b32 %[t1], %[t3]\n\t" "v_add_f32 %[t1], %[t1], %[t3]\n\t"
#define SCAN_PAIR1_ASM(OSA, OSB)                                                                              \
  SCAN_RED_HEAD(OSA) R1_2 SCAN_TAIL_W(OSA, R3_4, R5_6)                                                        \
  SCAN_RED_HEAD(OSB) SCAN_PY(OSA, "ya") SCAN_TAIL_W(OSB, R7_8, R9)                                            \
  SCAN_PY_LAST(OSB, "yb")
#define SCAN_PAIR2_ASM(OSA, OSB)                                                                              \
  SCAN_RED_HEAD(OSA) R10 SCAN_TAIL_W(OSA, R11, R12)                                                           \
  SCAN_RED_HEAD(OSB) SCAN_PY(OSA, "ya") SCAN_TAIL_W(OSB, R13_14, "s_nop 1\n\t")                               \
  SCAN_PY_LAST(OSB, "yb")
template <int FIRST>
DEVI void scan_pair(float& S0, float& S1, float& ya, float& yb, unsigned kk0, unsigned r0, unsigned kk1, unsigned r1,
                    unsigned u0, unsigned nk0, unsigned kd0, unsigned u1, unsigned nk1, unsigned kd1, unsigned vd) {
  float pp, tmp, T0, T1;
  if (FIRST)
    asm(SCAN_PAIR_ASM("1", "0")
        : [S0] "+v"(S0), [S1] "+v"(S1), [ya] "=&v"(ya), [yb] "=&v"(yb), [pp] "=&v"(pp), [tmp] "=&v"(tmp),
          [T0] "=&v"(T0), [T1] "=&v"(T1)
        : [kk0] "v"(kk0), [kk1] "v"(kk1), [u0] "v"(u0), [u1] "v"(u1), [vd] "v"(vd), [kd0] "v"(kd0), [kd1] "v"(kd1),
          [nk0] "v"(nk0), [nk1] "v"(nk1), [r0] "v"(r0), [r1] "v"(r1));
  else
    asm(SCAN_PAIR_ASM("0", "1")
        : [S0] "+v"(S0), [S1] "+v"(S1), [ya] "=&v"(ya), [yb] "=&v"(yb), [pp] "=&v"(pp), [tmp] "=&v"(tmp),
          [T0] "=&v"(T0), [T1] "=&v"(T1)
        : [kk0] "v"(kk0), [kk1] "v"(kk1), [u0] "v"(u0), [u1] "v"(u1), [vd] "v"(vd), [kd0] "v"(kd0), [kd1] "v"(kd1),
          [nk0] "v"(nk0), [nk1] "v"(nk1), [r0] "v"(r0), [r1] "v"(r1));
}
#define PAIR_IO [S0] "+v"(S0), [S1] "+v"(S1), [ya] "=&v"(ya), [yb] "=&v"(yb), [pp] "=&v"(pp), [tmp] "=&v"(tmp), [T0] "=&v"(T0), [T1] "=&v"(T1)
#define PAIR_IN [kk0] "v"(kk0), [kk1] "v"(kk1), [u0] "v"(u0), [u1] "v"(u1), [vd] "v"(vd), [kd0] "v"(kd0), [kd1] "v"(kd1), [nk0] "v"(nk0), [nk1] "v"(nk1), [r0] "v"(r0), [r1] "v"(r1)
template <int FIRST>
DEVI void scan_pair1(float& S0, float& S1, float& ya, float& yb, float& t1, float a0, float a1, float a2, float a3,
                     unsigned long long m0, unsigned long long m1, unsigned kk0, unsigned r0, unsigned kk1, unsigned r1,
                     unsigned u0, unsigned nk0, unsigned kd0, unsigned u1, unsigned nk1, unsigned kd1, unsigned vd) {
  float pp, tmp, T0, T1, t0, t2, t3;
  if (FIRST)
    asm(SCAN_PAIR1_ASM("1", "0")
        : PAIR_IO, [t0] "=&v"(t0), [t1] "=&v"(t1), [t2] "=&v"(t2), [t3] "=&v"(t3)
        : PAIR_IN, [a0] "v"(a0), [a1] "v"(a1), [a2] "v"(a2), [a3] "v"(a3), [m0] "s"(m0), [m1] "s"(m1));
  else
    asm(SCAN_PAIR1_ASM("0", "1")
        : PAIR_IO, [t0] "=&v"(t0), [t1] "=&v"(t1), [t2] "=&v"(t2), [t3] "=&v"(t3)
        : PAIR_IN, [a0] "v"(a0), [a1] "v"(a1), [a2] "v"(a2), [a3] "v"(a3), [m0] "s"(m0), [m1] "s"(m1));
}
template <int FIRST>
DEVI void scan_pair2(float& S0, float& S1, float& ya, float& yb, float& t1, unsigned kk0, unsigned r0, unsigned kk1,
                     unsigned r1, unsigned u0, unsigned nk0, unsigned kd0, unsigned u1, unsigned nk1, unsigned kd1,
                     unsigned vd) {
  float pp, tmp, T0, T1, t3;
  if (FIRST)
    asm(SCAN_PAIR2_ASM("1", "0") : PAIR_IO, [t1] "+v"(t1), [t3] "=&v"(t3) : PAIR_IN);
  else
    asm(SCAN_PAIR2_ASM("0", "1") : PAIR_IO, [t1] "+v"(t1), [t3] "=&v"(t3) : PAIR_IN);
}

DEVI float treduce4_asm(float a0, float a1, float a2, float a3, unsigned long long m0, unsigned long long m1) {
  float t0, t1, t2, t3;
  asm("v_cndmask_b32_e64 %[t1], %[a1], %[a0], %[m0]\n\t"
      "v_cndmask_b32_e64 %[t3], %[a3], %[a2], %[m0]\n\t"
      "v_cndmask_b32_e64 %[t0], %[a0], %[a1], %[m0]\n\t"
      "v_cndmask_b32_e64 %[t2], %[a2], %[a3], %[m0]\n\t"
      "v_add_f32_dpp %[t0], %[t1], %[t0] quad_perm:[1,0,3,2] row_mask:0xf bank_mask:0xf bound_ctrl:1\n\t"
      "v_add_f32_dpp %[t2], %[t3], %[t2] quad_perm:[1,0,3,2] row_mask:0xf bank_mask:0xf bound_ctrl:1\n\t"
      "s_nop 0\n\t"
      "v_cndmask_b32_e64 %[t3], %[t2], %[t0], %[m1]\n\t"
      "v_cndmask_b32_e64 %[t1], %[t0], %[t2], %[m1]\n\t"
      "s_nop 0\n\t"
      "v_add_f32_dpp %[t1], %[t3], %[t1] quad_perm:[2,3,0,1] row_mask:0xf bank_mask:0xf bound_ctrl:1\n\t"
      "s_nop 1\n\t"
      "v_add_f32_dpp %[t1], %[t1], %[t1] row_ror:4 row_mask:0xf bank_mask:0xf bound_ctrl:1\n\t"
      "s_nop 1\n\t"
      "v_add_f32_dpp %[t1], %[t1], %[t1] row_ror:8 row_mask:0xf bank_mask:0xf bound_ctrl:1\n\t"
      "v_mov_b32 %[t3], %[t1]\n\t"
      "s_nop 1\n\t"
      "v_permlane16_swap_b32 %[t1], %[t3]\n\t"
      "v_add_f32 %[t1], %[t1], %[t3]\n\t"
      "s_nop 0"
      : [t0] "=&v"(t0), [t1] "=&v"(t1), [t2] "=&v"(t2), [t3] "=&v"(t3)
      : [a0] "v"(a0), [a1] "v"(a1), [a2] "v"(a2), [a3] "v"(a3), [m0] "s"(m0), [m1] "s"(m1));
  return t1;
}

template <int DIR>
DEVI void scan_chain(const Params& p, int b, int h, int blk8, int wave, int lane, int tid, unsigned char* smem) {
  const int rs = lane >> 5, kp = lane & 31;
  const int row = blk8 * 8 + wave * 2 + rs;
  const unsigned char* base = p.ws + OFF_DI;
  _Float16* yacc = (_Float16*)(p.ws + OFF_P + (DIR ? 768 : 0)) + h * 64 + row;
  constexpr int SG = DIR ? -1 : 1;
#define TG0(chunk) ((chunk) < 8 ? 4096 + b * 64 + (DIR ? 63 - (chunk) * 8 : (chunk) * 8)                     \
                                : b * 2048 + (DIR ? 2047 - ((chunk) * 8 - 64) : ((chunk) * 8 - 64)))
  int C0, C1, C2, C3, C4, S0s, S1s, S2s, S3s, S4s;
#define PIECE(q, C, S)                                                                                       \
  {                                                                                                          \
    const int idx_ = tid + 256 * (q);                                                                        \
    const int g_ = idx_ / 160, r_ = idx_ - g_ * 160;                                                         \
    const bool di_ = r_ < 64;                                                                                \
    S = di_ ? 6144 : 9216;                                                                                   \
    C = (di_ ? h * 1024 + r_ * 16 : (int)SZ_DI + DIR * (int)SZ_DD1 + h * 1536 + (r_ - 64) * 16) + SG * g_ * S; \
  }
  PIECE(0, C0, S0s) PIECE(1, C1, S1s) PIECE(2, C2, S2s) PIECE(3, C3, S3s) PIECE(4, C4, S4s)
#undef PIECE
  const int tv = tid & 63;
  const int CV = (int)(SZ_DI + 2 * SZ_DD1) + (h * 64 + blk8 * 8) * 8 + (tv & 7) * 8 + SG * (tv >> 3) * 3072;
  uint4 st0, st1, st2, st3, st4;
  uint2 stv;
#define ISSUE(chunk)                                                                            \
  {                                                                                             \
    const int tg0_ = TG0(chunk);                                                                \
    st0 = *(const uint4*)(base + (unsigned)(C0 + tg0_ * S0s));                                  \
    st1 = *(const uint4*)(base + (unsigned)(C1 + tg0_ * S1s));                                  \
    st2 = *(const uint4*)(base + (unsigned)(C2 + tg0_ * S2s));                                  \
    st3 = *(const uint4*)(base + (unsigned)(C3 + tg0_ * S3s));                                  \
    st4 = *(const uint4*)(base + (unsigned)(C4 + tg0_ * S4s));                                  \
    stv = *(const uint2*)(base + (unsigned)(CV + tg0_ * 3072));                                 \
  }
#define WRITE(buf)                                                                              \
  {                                                                                             \
    unsigned char* d_ = smem + (buf) * CHUNK_B + tid * 16;                                      \
    *(uint4*)(d_) = st0;                                                                        \
    *(uint4*)(d_ + 4096) = st1;                                                                 \
    *(uint4*)(d_ + 8192) = st2;                                                                 \
    *(uint4*)(d_ + 12288) = st3;                                                                \
    *(uint4*)(d_ + 16384) = st4;                                                                \
    *(uint2*)(smem + (buf) * CHUNK_B + 20480 + tv * 8) = stv;                                   \
  }
  float S0 = 0.f, S1 = 0.f;
  const size_t yoff = (size_t)(lane & 3) * (PROWB / 2);
  _Float16* dump = (_Float16*)(p.ws + OFF_DUMP) + (size_t)(blk8 + 8 * (h + 6 * (2 * b + DIR))) * 512 + (tid & 255);
  float pa0 = 0.f, pa1 = 0.f, pa2 = 0.f, pa3 = 0.f;
  _Float16* yprev = dump;
  ISSUE(0);
  WRITE(0);
  ISSUE(1);
  __syncthreads();
#pragma unroll 1
  for (int chunk = 0; chunk < 264; ++chunk) {
    WRITE((chunk + 1) & 1);
    {
      const int cn = chunk + 2 < 264 ? chunk + 2 : 263;
      ISSUE(cn);
    }
    const unsigned char* B = smem + (chunk & 1) * CHUNK_B;
    const unsigned char* Bl = B + kp * 32;
    const unsigned char* Bd = B + 1024 + kp * 48;
    const unsigned char* Bv = B + 20480 + (wave * 2 + rs) * 8;
    _Float16* ydst = yacc + (size_t)(4 * TG0(chunk)) * (PROWB / 2) + yoff;
    ydst = kp < 4 ? ydst : dump;
    const long ystep = kp < 4 ? (long)SG * 4 * (long)(PROWB / 2) : 0;
    uint4 nd0 = *(const uint4*)(Bl), nd1 = *(const uint4*)(Bl + 16);
    uint4 ne0 = *(const uint4*)(Bd), ne1 = *(const uint4*)(Bd + 16), ne2 = *(const uint4*)(Bd + 32);
    uint2 nv = *(const uint2*)(Bv);
#pragma unroll
    for (int g = 0; g < 8; ++g) {
      const uint4 d0 = nd0, d1 = nd1, e0 = ne0, e1 = ne1, e2 = ne2;
      const uint2 vv = nv;
      if (g < 7) {
        nd0 = *(const uint4*)(Bl + (g + 1) * 2560);
        nd1 = *(const uint4*)(Bl + (g + 1) * 2560 + 16);
        ne0 = *(const uint4*)(Bd + (g + 1) * 2560);
        ne1 = *(const uint4*)(Bd + (g + 1) * 2560 + 16);
        ne2 = *(const uint4*)(Bd + (g + 1) * 2560 + 32);
        nv = *(const uint2*)(Bv + (g + 1) * 64);
      }
      float y0, y1, y2, y3, yv;
      const unsigned long long M0 = 0xAAAAAAAAAAAAAAAAull, M1 = 0xCCCCCCCCCCCCCCCCull;
      if (DIR == 0) {
        scan_pair1<0>(S0, S1, y0, y1, yv, pa0, pa1, pa2, pa3, M0, M1, d0.x, d0.z, d1.x, d1.z, e0.x, e0.z, e1.x, e1.z, e2.x, e2.z, vv.x);
        scan_pair2<0>(S0, S1, y2, y3, yv, d0.y, d0.w, d1.y, d1.w, e0.y, e0.w, e1.y, e1.w, e2.y, e2.w, vv.y);
      } else {
        scan_pair1<1>(S0, S1, y3, y2, yv, pa0, pa1, pa2, pa3, M0, M1, d0.y, d0.w, d1.y, d1.w, e0.y, e0.w, e1.y, e1.w, e2.y, e2.w, vv.y);
        scan_pair2<1>(S0, S1, y1, y0, yv, d0.x, d0.z, d1.x, d1.z, e0.x, e0.z, e1.x, e1.z, e2.x, e2.z, vv.x);
      }
      *yprev = (_Float16)yv;
      yprev = ydst + (long)g * ystep;
      pa0 = y0; pa1 = y1; pa2 = y2; pa3 = y3;
    }
    __syncthreads();
  }
  *yprev = (_Float16)treduce4_asm(pa0, pa1, pa2, pa3, 0xAAAAAAAAAAAAAAAAull, 0xCCCCCCCCCCCCCCCCull);
#undef TG0
#undef ISSUE
#undef WRITE
}

DEVI void attn_task(const Params& p, int l, int task, int lane) {
  const int fr = lane & 15, g = lane >> 4;
  u16* P = (u16*)(p.ws + OFF_P);
  const bool isctx = task >= 2048;
  int b, kvh, qt;
  if (!isctx) { qt = task & 511; kvh = (task >> 9) & 1; b = task >> 10; }
  else { const int t2 = task - 2048; qt = t2 & 15; kvh = (t2 >> 4) & 1; b = t2 >> 5; }
  const int q0 = qt * 16;
  const size_t qrow = isctx ? (size_t)(ML + b * 256 + q0 + fr) : (size_t)(b * 8192 + q0 + fr);
  u16* Pq = P + qrow * PW;
  bf16x8 qf[3][2];
#pragma unroll
  for (int hq = 0; hq < 3; ++hq)
#pragma unroll
    for (int s = 0; s < 2; ++s) qf[hq][s] = *(const bf16x8*)(Pq + C_Q + (kvh * 3 + hq) * 64 + s * 32 + g * 8);
  float mrun[3], lpart[3];
  f32x4 O[3][4];
#pragma unroll
  for (int hq = 0; hq < 3; ++hq) {
    mrun[hq] = p.at_sink[l * 6 + kvh * 3 + hq];
    lpart[hq] = g == 0 ? 1.f : 0.f;
#pragma unroll
    for (int dt = 0; dt < 4; ++dt) O[hq][dt] = f32x4{0.f, 0.f, 0.f, 0.f};
  }
  const int nwin = isctx ? 0 : 9;
  const u16* VT = (const u16*)(p.ws + OFF_VT) + (size_t)((b * 2 + kvh) * 64) * 8192;
  const u16* VTC = (const u16*)(p.ws + OFF_VTC) + (size_t)((b * 2 + kvh) * 64) * 256;

#define ATT_LOAD(it_, KF, VF)                                                                              \
  {                                                                                                        \
    const bool win_ = (it_) < nwin;                                                                        \
    const int kb_ = win_ ? (q0 - 128 + 32 * (it_)) : 32 * ((it_) - nwin);                                  \
    _Pragma("unroll") for (int tt = 0; tt < 2; ++tt) {                                                     \
      const int key = kb_ + 16 * tt + fr;                                                                  \
      size_t krow;                                                                                         \
      if (win_) { const int kc = key < 0 ? 0 : (key > 8191 ? 8191 : key); krow = (size_t)(b * 8192 + kc); } \
      else krow = (size_t)(ML + b * 256 + key);                                                            \
      _Pragma("unroll") for (int s = 0; s < 2; ++s)                                                        \
        KF[tt][s] = *(const bf16x8*)(P + krow * PW + C_KX + kvh * 64 + s * 32 + g * 8);                    \
    }                                                                                                      \
    _Pragma("unroll") for (int dt = 0; dt < 4; ++dt) {                                                     \
      const int d = dt * 16 + fr;                                                                          \
      uint2 lo, hi;                                                                                        \
      if (win_) {                                                                                          \
        int k1 = kb_ + 4 * g, k2 = kb_ + 16 + 4 * g;                                                       \
        if (k1 < 0 || k1 > 8188) k1 = 0;                                                                   \
        if (k2 < 0 || k2 > 8188) k2 = 0;                                                                   \
        lo = *(const uint2*)(VT + (size_t)d * 8192 + k1);                                                  \
        hi = *(const uint2*)(VT + (size_t)d * 8192 + k2);                                                  \
      } else {                                                                                             \
        lo = *(const uint2*)(VTC + d * 256 + kb_ + 4 * g);                                                 \
        hi = *(const uint2*)(VTC + d * 256 + kb_ + 16 + 4 * g);                                            \
      }                                                                                                    \
      uint4 cmb = uint4{lo.x, lo.y, hi.x, hi.y};                                                           \
      VF[dt] = __builtin_bit_cast(bf16x8, cmb);                                                            \
    }                                                                                                      \
  }
  const int nit = nwin + 8;
  bf16x8 nkf[2][2], nvf[4];
  ATT_LOAD(0, nkf, nvf);
#pragma unroll 1
  for (int it = 0; it < nit; ++it) {
    const bool win = it < nwin;
    const int kb = win ? (q0 - 128 + 32 * it) : 32 * (it - nwin);
    bf16x8 kf[2][2], vf[4];
#pragma unroll
    for (int tt = 0; tt < 2; ++tt)
#pragma unroll
      for (int s = 0; s < 2; ++s) kf[tt][s] = nkf[tt][s];
#pragma unroll
    for (int dt = 0; dt < 4; ++dt) vf[dt] = nvf[dt];
    {
      const int itn = it + 1 < nit ? it + 1 : it;
      ATT_LOAD(itn, nkf, nvf);
    }
#pragma unroll
    for (int hq = 0; hq < 3; ++hq) {
      f32x4 sa = f32x4{0.f, 0.f, 0.f, 0.f}, sb = f32x4{0.f, 0.f, 0.f, 0.f};
#pragma unroll
      for (int s = 0; s < 2; ++s) {
        sa = mfma16(kf[0][s], qf[hq][s], sa);
        sb = mfma16(kf[1][s], qf[hq][s], sb);
      }
      float sv[8];
#pragma unroll
      for (int i = 0; i < 4; ++i) {
        sv[i] = sa[i] * 0.125f;
        sv[4 + i] = sb[i] * 0.125f;
      }
      if (win) {
        const int qpos = q0 + fr;
#pragma unroll
        for (int i = 0; i < 8; ++i) {
          const int kpos = kb + 4 * g + (i & 3) + (i >> 2) * 16;
          const int df = qpos - kpos;
          const bool ok = kpos >= 0 && kpos < 8192 && df <= 128 && df >= -128;
          if (!ok) sv[i] = -1e30f;
        }
      }
      float tmax = sv[0];
#pragma unroll
      for (int i = 1; i < 8; ++i) tmax = fmaxf(tmax, sv[i]);
      {
        auto r16 = __builtin_amdgcn_permlane16_swap(__float_as_uint(tmax), __float_as_uint(tmax), false, false);
        tmax = fmaxf(__uint_as_float(r16[0]), __uint_as_float(r16[1]));
        auto r32 = __builtin_amdgcn_permlane32_swap(__float_as_uint(tmax), __float_as_uint(tmax), false, false);
        tmax = fmaxf(__uint_as_float(r32[0]), __uint_as_float(r32[1]));
      }
      const float mnew = fmaxf(mrun[hq], tmax);
      const float alpha = __expf(mrun[hq] - mnew);
      mrun[hq] = mnew;
      float ps = 0.f, pv[8];
#pragma unroll
      for (int i = 0; i < 8; ++i) {
        pv[i] = __expf(sv[i] - mnew);
        ps += pv[i];
      }
      lpart[hq] = lpart[hq] * alpha + ps;
      uint4 pk = uint4{pack2bf(pv[0], pv[1]), pack2bf(pv[2], pv[3]), pack2bf(pv[4], pv[5]), pack2bf(pv[6], pv[7])};
      const bf16x8 pf = __builtin_bit_cast(bf16x8, pk);
#pragma unroll
      for (int dt = 0; dt < 4; ++dt) {
        O[hq][dt] *= alpha;
        O[hq][dt] = mfma16(vf[dt], pf, O[hq][dt]);
      }
    }
  }
#pragma unroll
  for (int hq = 0; hq < 3; ++hq) {
    float lt = lpart[hq] + __shfl_xor(lpart[hq], 16);
    lt += __shfl_xor(lt, 32);
    const float inv = 1.f / lt;
#pragma unroll
    for (int dt = 0; dt < 4; ++dt) {
      u16* dst = Pq + C_GA + (kvh * 3 + hq) * 64 + dt * 16 + 4 * g;
      const uint2 gt = *(const uint2*)dst;
      const float g0 = bf2f((u16)(gt.x & 0xffff)), g1 = bf2f((u16)(gt.x >> 16));
      const float g2 = bf2f((u16)(gt.y & 0xffff)), g3 = bf2f((u16)(gt.y >> 16));
      uint2 o;
      o.x = pack2bf(O[hq][dt][0] * inv * silu_f(g0), O[hq][dt][1] * inv * silu_f(g1));
      o.y = pack2bf(O[hq][dt][2] * inv * silu_f(g2), O[hq][dt][3] * inv * silu_f(g3));
      *(uint2*)dst = o;
    }
  }
}

DEVI void mix_phase(const Params& p, int l, unsigned char* smem) {
  const int tid = TIDX, bid = BIDX;
  const int lane = tid & 63, wave = __builtin_amdgcn_readfirstlane(tid >> 6);
  const int G = (int)gridDim.x;
  const bool iso = (G == 512);
  if (bid < SCAN_BLOCKS) {
    const int xcd = bid & 7, idx = bid >> 3;
    const int chain = xcd * 3 + (idx >> 3), blk8 = idx & 7;
    const int dir = chain & 1, h = (chain >> 1) % 6, b = chain / 12;
    if (dir == 0) scan_chain<0>(p, b, h, blk8, wave, lane, tid, smem);
    else scan_chain<1>(p, b, h, blk8, wave, lane, tid, smem);
  } else {
    unsigned* cnt = (unsigned*)(p.ws + OFF_BAR) + XCD_BAR_WORDS + 64 * l;
    const bool attn_blk = !iso || !(bid >= 256 && bid < 256 + SCAN_BLOCKS);
    int ab, nab;
    if (iso) {
      ab = bid < 256 ? bid - SCAN_BLOCKS : bid - 256 - SCAN_BLOCKS + (256 - SCAN_BLOCKS);
      nab = 2 * (256 - SCAN_BLOCKS);
    } else {
      ab = bid - SCAN_BLOCKS;
      nab = G - SCAN_BLOCKS;
    }
    float* tilef = (float*)smem;
    if (attn_blk) {
      const int aw = ab * 4 + wave, naw = nab * 4;
      const int ntask = 2048 + (l < 3 ? 64 : 0);
      conv_items(p, l, ab * 256 + tid, nab * 256);
      for (int t = aw; t < ntask; t += naw) attn_task(p, l, t, lane);
      convert_weight(p.w_out + (size_t)l * 1024 * 1024, 1024, 1024, (u16*)(p.ws + OFF_WOUTT), tilef, ab, nab);
      asm volatile("s_waitcnt vmcnt(0)" ::: "memory");
      __syncthreads();
      if (tid == 0) {
        __builtin_amdgcn_fence(__ATOMIC_RELEASE, "agent");
        asm volatile("s_waitcnt vmcnt(0)" ::: "memory");
        xb_add(cnt, 1u);
      }
    }
    if (!attn_blk) {
      if (l < 3)
        convert_weight(p.w_in + (size_t)(l + 1) * 1024 * 3840, 1024, 3840, (u16*)(p.ws + OFF_WINT), tilef, bid - 256,
                       SCAN_BLOCKS);
      return;
    }
    if (tid == 0) {
      unsigned sp = 0;
      while (xb_ld(cnt) < (unsigned)nab) {
        __builtin_amdgcn_s_sleep(8);
        if (++sp > (1u << 24)) break;
      }
      __builtin_amdgcn_fence(__ATOMIC_ACQUIRE, "agent");
      asm volatile("s_waitcnt vmcnt(0)" ::: "memory");
    }
    __syncthreads();
    gemm_phase<2>(p, l, smem, ab, nab);
    if (l < 3 && !iso)
      convert_weight(p.w_in + (size_t)(l + 1) * 1024 * 3840, 1024, 3840, (u16*)(p.ws + OFF_WINT), tilef, ab, nab);
  }
}

DEVI void post_phase(const Params& p, int l) {
  const int tid = TIDX;
  const int lane = tid & 63, j = lane >> 4, q = lane & 15;
  const int gw = BIDX * 4 + (tid >> 6), nw = gridDim.x * 4;
  const int ntask = ((l < 3 ? MT : ML) / 4) * 6;
  const float* bonus = (const float*)(p.ws + OFF_BONUS);
  for (int it = gw; it < ntask; it += nw) {
    const int tg = it / 6, h = it - tg * 6;
    const int m = tg * 4 + j;
    unsigned char* rowb = p.ws + OFF_P + (size_t)m * PROWB;
    const h4 yf = *(const h4*)(rowb + (h * 64 + 4 * q) * 2);
    const h4 yb = *(const h4*)(rowb + 768 + (h * 64 + 4 * q) * 2);
    const float4 lg = *(const float4*)(p.rw_ln_g + l * 384 + h * 64 + 4 * q);
    const float4 lb = *(const float4*)(p.rw_ln_b + l * 384 + h * 64 + 4 * q);
    const unsigned char* v4 = p.ws + OFF_V4 + ((size_t)(tg * 6 + h) * 64 + 4 * q) * 8 + j * 2;
    const float va = (float)(*(const _Float16*)(v4)), vb = (float)(*(const _Float16*)(v4 + 8));
    const float vc = (float)(*(const _Float16*)(v4 + 16)), vd = (float)(*(const _Float16*)(v4 + 24));
    u16* gp = (u16*)rowb + C_G + h * 64 + 4 * q;
    const uint2 gv = *(const uint2*)gp;
    const float bon = bonus[(size_t)m * 6 + h];
    const float y0 = (float)yf[0] + (float)yb[0], y1 = (float)yf[1] + (float)yb[1], y2 = (float)yf[2] + (float)yb[2], y3 = (float)yf[3] + (float)yb[3];
    const float mu = reduce16(y0 + y1 + y2 + y3) * (1.f / 64.f);
    const float d0 = y0 - mu, d1 = y1 - mu, d2 = y2 - mu, d3 = y3 - mu;
    const float var = reduce16(d0 * d0 + d1 * d1 + d2 * d2 + d3 * d3) * (1.f / 64.f);
    const float rstd = rsqrtf(var + 64e-5f);
    const float g0 = bf2f((u16)(gv.x & 0xffff)), g1 = bf2f((u16)(gv.x >> 16));
    const float g2 = bf2f((u16)(gv.y & 0xffff)), g3 = bf2f((u16)(gv.y >> 16));
    uint2 o;
    o.x = pack2bf((d0 * rstd * lg.x + lb.x + bon * va) * silu_f(g0), (d1 * rstd * lg.y + lb.y + bon * vb) * silu_f(g1));
    o.y = pack2bf((d2 * rstd * lg.z + lb.z + bon * vc) * silu_f(g2), (d3 * rstd * lg.w + lb.w + bon * vd) * silu_f(g3));
    *(uint2*)gp = o;
  }
}

DEVI void final_phase(const Params& p) {
  const int tid = TIDX;
  const int lane = tid & 63;
  const int gw = BIDX * 4 + (tid >> 6), nw = gridDim.x * 4;
  for (int m = gw; m < ML; m += nw) {
    float* row = p.out + (size_t)m * 1024;
    float4 v[4];
    float ss = 0.f;
#pragma unroll
    for (int i = 0; i < 4; ++i) {
      v[i] = *(const float4*)(row + i * 256 + lane * 4);
      ss += v[i].x * v[i].x + v[i].y * v[i].y + v[i].z * v[i].z + v[i].w * v[i].w;
    }
    ss = wave_sum(ss);
    const float inv = rsqrtf(ss * (1.f / 1024.f) + 1e-6f);
#pragma unroll
    for (int i = 0; i < 4; ++i) {
      const int c0 = i * 256 + lane * 4;
      const float4 g4 = *(const float4*)(p.final_g + c0);
      float4 o;
      o.x = v[i].x * inv * g4.x; o.y = v[i].y * inv * g4.y; o.z = v[i].z * inv * g4.z; o.w = v[i].w * inv * g4.w;
      *(float4*)(row + c0) = o;
    }
  }
}


#ifndef PROBE_PHASE
#define PROBE_PHASE -1
#endif
#define PB_START() if (PROBE_PHASE >= 0) { pb_t0 = wall_clock64(); }
#define PB_END(id) if (PROBE_PHASE == (id)) { pb_acc += (long long)wall_clock64() - pb_t0; }
__global__ void __launch_bounds__(256, 2) mk_kernel(Params p) {
  __shared__ __attribute__((aligned(16))) unsigned char smem[65536];
  __shared__ uint4 xb_words;
  cg::grid_group grid = cg::this_grid();
  long long pb_t0 = 0, pb_acc = 0;
  unsigned* bar = (unsigned*)(p.ws + OFF_BAR);
  if (threadIdx.x == 0) xb_words = make_uint4(0u, 0u, 0u, 0u);
  __syncthreads();
  if (p.ws == nullptr) grid.sync();
  XcdBarrier xb = xcd_barrier_post(bar, (volatile LAS unsigned*)&xb_words);
  PB_START();
  prologue_phase(p, smem);
  xcd_barrier(xb);
  PB_END(0);
#pragma unroll 1
  for (int l = 0; l < 4; ++l) {
    if (PROBE_PHASE == 8) { PB_START(); xcd_barrier(xb); PB_END(8); }
    PB_START();
    norm_phase(p, l);
    xcd_barrier(xb);
    PB_END(1);
    PB_START();
    gemm_phase<0>(p, l, smem, BIDX, (int)gridDim.x);
    xcd_barrier(xb);
    PB_END(2);
    PB_START();
    prep_phase(p, l, smem);
    xcd_barrier(xb);
    PB_END(3);
    PB_START();
    mix_phase(p, l, smem);
    xcd_barrier(xb);
    PB_END(4);
    PB_START();
    post_phase(p, l);
    xcd_barrier(xb);
    PB_END(5);
    PB_START();
    gemm_phase<1>(p, l, smem, BIDX, (int)gridDim.x);
    xcd_barrier(xb);
    PB_END(6);
  }
  final_phase(p);
  if (PROBE_PHASE >= 0) {
    xcd_barrier(xb);
    if (blockIdx.x == 0) {
      long long k = pb_acc / 20;
      if (k > 60000) k = 60000;
      for (int i = threadIdx.x; i < (int)k; i += 256) p.out[i] += 0.125f;
    }
  }
}

extern "C" void kernel_launch(void* const* d_in, const int* in_sizes, int n_in, void* d_out, int out_size,
                              void* d_ws, size_t ws_size, hipStream_t stream) {
  static int grid_blocks = 0;
  if (!grid_blocks) {
    int dev = 0, cus = 0, per_cu = 0;
    (void)hipGetDevice(&dev);
    (void)hipDeviceGetAttribute(&cus, hipDeviceAttributeMultiprocessorCount, dev);
    (void)hipOccupancyMaxActiveBlocksPerMultiprocessor(&per_cu, mk_kernel, 256, 0);
    if (per_cu > 2) per_cu = 2;
    if (per_cu < 1) per_cu = 1;
    grid_blocks = cus * per_cu;
  }
  Params p{};
  const float** pp = (const float**)&p;
  for (int i = 0; i < 21; ++i) pp[i] = (const float*)d_in[i];
  p.out = (float*)d_out;
  p.ws = (unsigned char*)d_ws;
  (void)hipMemsetAsync((unsigned char*)d_ws + OFF_BAR, 0, (XCD_BAR_WORDS + 256) * 4, stream);
  void* args[] = {&p};
  hipError_t e = hipLaunchCooperativeKernel((void*)mk_kernel, dim3(grid_blocks), dim3(256), args, 0, stream);
  if (e != hipSuccess) fprintf(stderr, "coop launch failed: %s (grid %d)\n", hipGetErrorString(e), grid_blocks);
}
```

```cpp
#include <hip/hip_runtime.h>
#include <hip/hip_bf16.h>
#include <hip/hip_cooperative_groups.h>
#include <cstdio>
namespace cg = cooperative_groups;

typedef unsigned short u16;
typedef __attribute__((ext_vector_type(8))) short bf16x8;
typedef __attribute__((ext_vector_type(4))) float f32x4;
typedef _Float16 h8 __attribute__((ext_vector_type(8)));
typedef _Float16 h4 __attribute__((ext_vector_type(4)));

#define DEVI __device__ __forceinline__

constexpr int PW = 3328;
constexpr size_t PROWB = 6656;
constexpr int MT = 16896;
constexpr int ML = 16384;
constexpr int C_R = 0, C_K = 384, C_G = 768, C_WD = 1152, C_AD = 1280, C_Q = 1408, C_KX = 1792,
              C_GA = 1920, C_BG = 2304, C_CG = 2560, C_XIN = 2816, C_GCV = 3072;
constexpr size_t OFF_P = 0;
constexpr size_t OFF_DI = 112459776;
constexpr size_t SZ_DI = 25952256;
constexpr size_t OFF_DD = OFF_DI + SZ_DI;
constexpr size_t SZ_DD1 = 38928384;
constexpr size_t OFF_V4 = OFF_DD + 2 * SZ_DD1;
constexpr size_t OFF_H = OFF_DI;
constexpr size_t OFF_WINT = OFF_DI + 116785152;
constexpr size_t OFF_WOUTT = OFF_WINT + 7864320;
constexpr size_t OFF_LORA = OFF_WOUTT + 2097152;
constexpr size_t OFF_MOD = OFF_LORA + 786432;
constexpr size_t OFF_XC = OFF_MOD + 147456;
constexpr size_t OFF_ROPE = OFF_XC + 2097152;
constexpr size_t OFF_VT = OFF_ROPE + 16384;
constexpr size_t OFF_VTC = OFF_VT + 4194304;
constexpr size_t OFF_BONUS = OFF_VTC + 131072;
constexpr size_t OFF_BAR = OFF_BONUS + 405504;
constexpr size_t OFF_DUMP = OFF_BAR + 16384;

constexpr int SCAN_BLOCKS = 192;

struct Params {
  const float *x, *c, *ctx, *c_ctx, *w_ada, *b_ada, *norm_g, *w_in, *w_out, *rw_w0, *rw_w_up, *rw_a0,
      *rw_a_up, *rw_k_k, *rw_k_a, *rw_r_k, *rw_ln_g, *rw_ln_b, *at_sink, *cv_w, *final_g;
  float* out;
  unsigned char* ws;
};

typedef __bf16 bf2_t __attribute__((ext_vector_type(2)));
typedef float f2_t __attribute__((ext_vector_type(2)));
DEVI unsigned pack2bf(float a, float b) {
  f2_t v = {a, b};
  return __builtin_bit_cast(unsigned, __builtin_convertvector(v, bf2_t));
}
DEVI u16 f2bf(float f) { return (u16)(pack2bf(f, 0.f) & 0xffffu); }
DEVI float bf2f(u16 h) { return __uint_as_float(((unsigned)h) << 16); }
DEVI float sigmoid_f(float x) { return 1.f / (1.f + __expf(-x)); }
DEVI float silu_f(float x) { return x / (1.f + __expf(-x)); }
DEVI float tanh_f(float x) { return 1.f - 2.f / (1.f + __expf(2.f * x)); }
DEVI f32x4 mfma16(bf16x8 a, bf16x8 b, f32x4 c) { return __builtin_amdgcn_mfma_f32_16x16x32_bf16(a, b, c, 0, 0, 0); }

DEVI int opaque_v(int x) { asm volatile("" : "+v"(x)); return x; }
DEVI int opaque_s(int x) { asm volatile("" : "+s"(x)); return x; }
#define TIDX opaque_v((int)threadIdx.x)
#define BIDX opaque_s((int)blockIdx.x)

template <int CTRL>
DEVI float dppf(float x) {
  return __int_as_float(__builtin_amdgcn_update_dpp(0, __float_as_int(x), CTRL, 0xF, 0xF, true));
}
DEVI float reduce32(float x) {
  x += dppf<0xB1>(x);
  x += dppf<0x4E>(x);
  x += dppf<0x141>(x);
  x += dppf<0x140>(x);
  auto r = __builtin_amdgcn_permlane16_swap(__float_as_uint(x), __float_as_uint(x), false, false);
  return __uint_as_float(r[0]) + __uint_as_float(r[1]);
}
template <int HS> DEVI float mixA(unsigned h, float b) {
  float d;
  if (HS) asm("v_fma_mix_f32 %0, %1, %2, 0 op_sel:[1,0,0] op_sel_hi:[1,0,0]" : "=v"(d) : "v"(h), "v"(b));
  else asm("v_fma_mix_f32 %0, %1, %2, 0 op_sel:[0,0,0] op_sel_hi:[1,0,0]" : "=v"(d) : "v"(h), "v"(b));
  return d;
}
template <int HS> DEVI float mixB(unsigned h, float b, float c) {
  float d;
  if (HS) asm("v_fma_mix_f32 %0, %1, %2, %3 op_sel:[1,0,0] op_sel_hi:[1,0,0]" : "=v"(d) : "v"(h), "v"(b), "v"(c));
  else asm("v_fma_mix_f32 %0, %1, %2, %3 op_sel:[0,0,0] op_sel_hi:[1,0,0]" : "=v"(d) : "v"(h), "v"(b), "v"(c));
  return d;
}
template <int HS> DEVI float mixBn(unsigned h, float b, float c) {
  float d;
  if (HS) asm("v_fma_mix_f32 %0, %1, %2, %3 op_sel:[1,0,0] op_sel_hi:[1,0,0]\n\ts_nop 1" : "=v"(d) : "v"(h), "v"(b), "v"(c));
  else asm("v_fma_mix_f32 %0, %1, %2, %3 op_sel:[0,0,0] op_sel_hi:[1,0,0]\n\ts_nop 1" : "=v"(d) : "v"(h), "v"(b), "v"(c));
  return d;
}
template <int HS> DEVI float mixC(unsigned h, float b, float c) {
  float d;
  if (HS) asm("v_fma_mix_f32 %0, -%1, %2, %3 op_sel:[1,0,0] op_sel_hi:[1,0,0]" : "=v"(d) : "v"(h), "v"(b), "v"(c));
  else asm("v_fma_mix_f32 %0, -%1, %2, %3 op_sel:[0,0,0] op_sel_hi:[1,0,0]" : "=v"(d) : "v"(h), "v"(b), "v"(c));
  return d;
}
template <int HS> DEVI float mixD(unsigned h1, unsigned h2, float c) {
  float d;
  if (HS) asm("v_fma_mix_f32 %0, %1, %2, %3 op_sel:[1,1,0] op_sel_hi:[1,1,0]" : "=v"(d) : "v"(h1), "v"(h2), "v"(c));
  else asm("v_fma_mix_f32 %0, %1, %2, %3 op_sel:[0,0,0] op_sel_hi:[1,1,0]" : "=v"(d) : "v"(h1), "v"(h2), "v"(c));
  return d;
}
DEVI float reduce16(float x) {
  x += dppf<0xB1>(x);
  x += dppf<0x4E>(x);
  x += dppf<0x141>(x);
  x += dppf<0x140>(x);
  return x;
}

template <int HS> DEVI float mixAn(unsigned h, float b) {
  float d;
  if (HS) asm("v_fma_mix_f32 %0, %1, %2, 0 op_sel:[1,0,0] op_sel_hi:[1,0,0]\n\ts_nop 1" : "=v"(d) : "v"(h), "v"(b));
  else asm("v_fma_mix_f32 %0, %1, %2, 0 op_sel:[0,0,0] op_sel_hi:[1,0,0]\n\ts_nop 1" : "=v"(d) : "v"(h), "v"(b));
  return d;
}
template <int HS> DEVI float mixBs(unsigned h, float bs, float c) {
  float d;
  if (HS) asm("v_fma_mix_f32 %0, %1, %2, %3 op_sel:[1,0,0] op_sel_hi:[1,0,0]" : "=v"(d) : "v"(h), "s"(bs), "v"(c));
  else asm("v_fma_mix_f32 %0, %1, %2, %3 op_sel:[0,0,0] op_sel_hi:[1,0,0]" : "=v"(d) : "v"(h), "s"(bs), "v"(c));
  return d;
}
template <int CTRL, int RM>
DEVI float dppf_rm(float x) {
  return __int_as_float(__builtin_amdgcn_update_dpp(0, __float_as_int(x), CTRL, RM, 0xF, false));
}
DEVI float reduce64_hi(float x) {
  x += dppf<0xB1>(x);
  x += dppf<0x4E>(x);
  x += dppf<0x141>(x);
  x += dppf<0x140>(x);
  x += dppf_rm<0x142, 0xA>(x);
  x += dppf_rm<0x143, 0xC>(x);
  return x;
}

DEVI float wave_sum(float x) {
  x = reduce64_hi(x);
  return __int_as_float(__builtin_amdgcn_readlane(__float_as_int(x), 63));
}

#define XB_TMO      128
#define XB_XCNT(j)  (256  + 64 * (j))
#define XB_XSUB(j)  (1280 + 64 * (j))
#define XB_XGEN(j)  (2304 + 64 * (j))
#define XB_TOP      3328
#define XB_TOPGEN   3392
#define XCD_BAR_WORDS 3456
#define XB_SPIN_CAP (1u << 22)
#define LAS __attribute__((address_space(3)))
DEVI unsigned xb_ld(unsigned* p) { return __hip_atomic_load(p, __ATOMIC_RELAXED, __HIP_MEMORY_SCOPE_AGENT); }
DEVI unsigned xb_add(unsigned* p, unsigned v) { return __hip_atomic_fetch_add(p, v, __ATOMIC_RELAXED, __HIP_MEMORY_SCOPE_AGENT); }
DEVI unsigned xb_xcc_id() { return (unsigned)__builtin_amdgcn_s_getreg((3 << 11) | 20) & 0xFu; }
#define XB_SPIN(cond, bar) do { unsigned _sp = 0; while (cond) { __builtin_amdgcn_s_sleep(1); \
    if ((++_sp & 255u) == 0u) { if (xb_ld(&(bar)[XB_TMO])) break; if (_sp > XB_SPIN_CAP) { atomicAdd(&(bar)[XB_TMO], 1u); break; } } } } while (0)
struct XcdBarrier { unsigned* bar; unsigned x; volatile LAS unsigned* st; };
DEVI XcdBarrier xcd_barrier_post(unsigned* bar, volatile LAS unsigned* st) {
  XcdBarrier b; b.bar = bar; b.x = xb_xcc_id(); b.st = st;
  if (threadIdx.x == 0) (void)xb_add(&bar[XB_XCNT(b.x)], 1u);
  return b;
}
DEVI void xcd_barrier_complete(unsigned* bar, unsigned x, unsigned& nloc, unsigned& nx) {
  const unsigned G = gridDim.x * gridDim.y * gridDim.z;
  unsigned sum, cnt, mine, sp = 0u;
  for (;;) {
    sum = 0u; cnt = 0u; mine = 0u;
#pragma unroll
    for (unsigned j = 0; j < 16; ++j) { const unsigned c = xb_ld(&bar[XB_XCNT(j)]); sum += c; cnt += (c > 0u) ? 1u : 0u; mine = (j == x) ? c : mine; }
    if (sum == G) break;
    __builtin_amdgcn_s_sleep(1);
    if ((++sp & 255u) == 0u) { if (xb_ld(&bar[XB_TMO])) break; if (sp > XB_SPIN_CAP) { atomicAdd(&bar[XB_TMO], 1u); break; } }
  }
  nloc = mine > 0u ? mine : 1u; nx = cnt > 0u ? cnt : 1u;
}
DEVI void xcd_barrier(const XcdBarrier& b) {
  asm volatile("s_waitcnt vmcnt(0)" ::: "memory");
  __syncthreads();
  if (threadIdx.x == 0) {
    unsigned* bar = b.bar;
    __builtin_amdgcn_s_waitcnt(0);
    unsigned nloc = b.st[0], nx = b.st[1];
    if (nloc == 0u) { xcd_barrier_complete(bar, b.x, nloc, nx); b.st[0] = nloc; b.st[1] = nx; }
    const unsigned old = xb_add(&bar[XB_XSUB(b.x)], 1u);
    const unsigned gen = old / nloc;
    if (old + 1u == (gen + 1u) * nloc) {
      __builtin_amdgcn_fence(__ATOMIC_RELEASE, "agent");
      asm volatile("s_waitcnt vmcnt(0)" ::: "memory");
      const unsigned og = xb_add(&bar[XB_TOP], 1u);
      const unsigned tg = og / nx;
      if (og + 1u == (tg + 1u) * nx) xb_add(&bar[XB_TOPGEN], 1u);
      else XB_SPIN(xb_ld(&bar[XB_TOPGEN]) == tg, bar);
      __builtin_amdgcn_fence(__ATOMIC_ACQUIRE, "agent");
      xb_add(&bar[XB_XGEN(b.x)], 1u);
      asm volatile("s_waitcnt vmcnt(0)" ::: "memory");
    } else {
      XB_SPIN(xb_ld(&bar[XB_XGEN(b.x)]) == gen, bar);
      __builtin_amdgcn_fence(__ATOMIC_ACQUIRE, "agent");
      asm volatile("s_waitcnt vmcnt(0)" ::: "memory");
    }
  }
  __syncthreads();
}

DEVI void transpose_tile(const float* __restrict__ src, int N, int K, int k0, int n0, u16* __restrict__ dst,
                         float* tile) {
  const int tid = TIDX;
  for (int e = tid; e < 4096; e += 256) {
    int r = e >> 6, cc = e & 63;
    tile[r * 65 + cc] = src[(size_t)(k0 + r) * N + n0 + cc];
  }
  __syncthreads();
  for (int e = tid; e < 4096; e += 256) {
    int n = e >> 6, k = e & 63;
    dst[(size_t)(n0 + n) * K + k0 + k] = f2bf(tile[k * 65 + n]);
  }
  __syncthreads();
}
DEVI void convert_weight(const float* src, int K, int N, u16* dst, float* tile, int t0, int stride) {
  const int nk = K >> 6, nn = N >> 6;
  for (int t = t0; t < nk * nn; t += stride) transpose_tile(src, N, K, (t % nk) * 64, (t / nk) * 64, dst, tile);
}

DEVI void mod_task(const Params& p, int task, float* sm) {
  const int l = task / 48, n0 = (task % 48) * 64;
  const int tid = TIDX;
  for (int e = tid; e < 3072; e += 256) {
    int bi = e >> 10, k = e & 1023;
    float v = bi < 2 ? p.c[bi * 1024 + k] : p.c_ctx[k];
    sm[e] = silu_f(v);
  }
  __syncthreads();
  const int c4 = tid & 15, kg = tid >> 4;
  const float* w = p.w_ada + (size_t)l * 1024 * 3072 + n0 + c4 * 4;
  float4 a0 = float4{0.f, 0.f, 0.f, 0.f}, a1 = a0, a2 = a0;
#pragma unroll 16
  for (int k = kg * 64; k < kg * 64 + 64; ++k) {
    const float4 wv = *(const float4*)(w + (size_t)k * 3072);
    const float s0 = sm[k], s1 = sm[1024 + k], s2 = sm[2048 + k];
    a0.x += s0 * wv.x; a0.y += s0 * wv.y; a0.z += s0 * wv.z; a0.w += s0 * wv.w;
    a1.x += s1 * wv.x; a1.y += s1 * wv.y; a1.z += s1 * wv.z; a1.w += s1 * wv.w;
    a2.x += s2 * wv.x; a2.y += s2 * wv.y; a2.z += s2 * wv.z; a2.w += s2 * wv.w;
  }
  float* red = sm + 3072;
  *(float4*)(red + (kg * 3 + 0) * 64 + c4 * 4) = a0;
  *(float4*)(red + (kg * 3 + 1) * 64 + c4 * 4) = a1;
  *(float4*)(red + (kg * 3 + 2) * 64 + c4 * 4) = a2;
  __syncthreads();
  if (tid < 192) {
    int bi = tid >> 6, cc = tid & 63;
    float s = p.b_ada[l * 3072 + n0 + cc];
    for (int q = 0; q < 16; ++q) s += red[(q * 3 + bi) * 64 + cc];
    float* mod = (float*)(p.ws + OFF_MOD);
    mod[(l * 3 + bi) * 3072 + n0 + cc] = s;
  }
  __syncthreads();
}

DEVI void prologue_phase(const Params& p, unsigned char* smem) {
  float* tile = (float*)smem;
  const int bid = BIDX;
  convert_weight(p.w_in, 1024, 3840, (u16*)(p.ws + OFF_WINT), tile, bid, gridDim.x);
  for (int t = bid; t < 96; t += gridDim.x) {
    int ct = t % 6, mat = t / 6;
    int kind = mat & 1, ld = mat >> 1;
    const float* src = (kind ? p.rw_a_up : p.rw_w_up) + (size_t)ld * 64 * 384;
    transpose_tile(src, 384, 64, 0, ct * 64, (u16*)(p.ws + OFF_LORA) + (size_t)mat * 384 * 64, tile);
  }
  for (int t = bid; t < 192; t += gridDim.x) mod_task(p, t, tile);
  if (bid == (int)gridDim.x - 1) {
    float* rope = (float*)(p.ws + OFF_ROPE);
    for (int e = TIDX; e < 2048; e += 256) {
      int pos = e >> 4, f = e & 15;
      float inv = exp2f(-(float)f * (13.287712379549449f / 16.f));
      float ang = (float)pos * inv;
      rope[e * 2] = cosf(ang);
      rope[e * 2 + 1] = sinf(ang);
    }
  }
}

DEVI void norm_phase(const Params& p, int l) {
  const int tid = TIDX;
  const int lane = tid & 63;
  const int gw = BIDX * 4 + (tid >> 6), nw = gridDim.x * 4;
  const float* xs = l == 0 ? p.x : p.out;
  const float* xcs = l == 0 ? p.ctx : (const float*)(p.ws + OFF_XC);
  const float* mod = (const float*)(p.ws + OFF_MOD) + (size_t)l * 3 * 3072;
  const float* ng = p.norm_g + l * 1024;
  u16* H = (u16*)(p.ws + OFF_H);
  for (int m = gw; m < MT; m += nw) {
    const float* row = m < ML ? xs + (size_t)m * 1024 : xcs + (size_t)(m - ML) * 1024;
    const int bi = m < 8192 ? 0 : (m < ML ? 1 : 2);
    float4 v[4];
    float ss = 0.f;
#pragma unroll
    for (int i = 0; i < 4; ++i) {
      v[i] = *(const float4*)(row + i * 256 + lane * 4);
      ss += v[i].x * v[i].x + v[i].y * v[i].y + v[i].z * v[i].z + v[i].w * v[i].w;
    }
    ss = wave_sum(ss);
    const float inv = rsqrtf(ss * (1.f / 1024.f) + 1e-6f);
    const float* md = mod + bi * 3072;
#pragma unroll
    for (int i = 0; i < 4; ++i) {
      const int c0 = i * 256 + lane * 4;
      float4 g4 = *(const float4*)(ng + c0);
      float4 sh = *(const float4*)(md + c0);
      float4 sc = *(const float4*)(md + 1024 + c0);
      float o0 = v[i].x * inv * g4.x * (1.f + sc.x) + sh.x;
      float o1 = v[i].y * inv * g4.y * (1.f + sc.y) + sh.y;
      float o2 = v[i].z * inv * g4.z * (1.f + sc.z) + sh.z;
      float o3 = v[i].w * inv * g4.w * (1.f + sc.w) + sh.w;
      uint2 pk;
      pk.x = pack2bf(o0, o1);
      pk.y = pack2bf(o2, o3);
      *(uint2*)(H + (size_t)m * 1024 + c0) = pk;
    }
  }
}

template <int MODE>
DEVI void gemm_phase(const Params& p, int l, unsigned char* smem, int tb0, int tbs) {
  constexpr int KT0 = MODE == 2 ? 6 : 0;
  constexpr int NKT = MODE == 0 ? 16 : (MODE == 1 ? 6 : 10);
  u16* sA = (u16*)smem;
  u16* sB = sA + 128 * 64;
  const int tid = TIDX, lane = tid & 63, wave = tid >> 6, wm = wave >> 1, wn = wave & 1;
  const int fr = lane & 15, g = lane >> 4;
  const int ntn = MODE == 0 ? 30 : 8;
  const int ntm = MODE == 0 ? 132 : (l < 3 ? 132 : 128);
  const bool TRfix = MODE != 0;
  const u16* A = MODE == 0 ? (const u16*)(p.ws + OFF_H) : (const u16*)(p.ws + OFF_P);
  const int lda = MODE == 0 ? 1024 : PW;
  const u16* Bt = MODE == 0 ? (const u16*)(p.ws + OFF_WINT) : (const u16*)(p.ws + OFF_WOUTT);
  u16* P = (u16*)(p.ws + OFF_P);

  const int ntiles = ntm * ntn;
#define TILE_OF(t0v) ((MODE != 2 && tbs == 512) ? (((t0v) & ~511) + (((t0v) & 7) << 6) + (((t0v) & 511) >> 3)) : (t0v))
  const int lrow = tid >> 3, lseg = tid & 7;
  const int soff = lrow * 64 + ((lseg ^ ((lrow >> 1) & 7)) << 3);
  uint4 xa0, xa1, xa2, xa3, xb0, xb1, xb2, xb3;
  uint4 ya0, ya1, ya2, ya3, yb0, yb1, yb2, yb3;
  const u16* aptr;
  const u16* bptr;
#define ACOL(kt) (MODE == 0 ? (kt) * 64 : ((kt) < 6 ? C_G + (kt) * 64 : ((kt) < 12 ? C_GA + ((kt) - 6) * 64 : C_BG + ((kt) - 12) * 64)))
#define GLOAD(P, kt)                                                           \
  {                                                                            \
    const int acol_ = ACOL(kt);                                                \
    P##a0 = *(const uint4*)(aptr + acol_);                                     \
    P##a1 = *(const uint4*)(aptr + (size_t)32 * lda + acol_);                  \
    P##a2 = *(const uint4*)(aptr + (size_t)64 * lda + acol_);                  \
    P##a3 = *(const uint4*)(aptr + (size_t)96 * lda + acol_);                  \
    P##b0 = *(const uint4*)(bptr + (kt) * 64);                                 \
    P##b1 = *(const uint4*)(bptr + 32 * 1024 + (kt) * 64);                     \
    P##b2 = *(const uint4*)(bptr + 64 * 1024 + (kt) * 64);                     \
    P##b3 = *(const uint4*)(bptr + 96 * 1024 + (kt) * 64);                     \
  }
#define SSTORE(P, buf)                                                         \
  {                                                                            \
    u16* sa_ = sA + (buf) * 16384 + soff;                                      \
    u16* sb_ = sa_ + 128 * 64;                                                 \
    *(uint4*)(sa_) = P##a0;                                                    \
    *(uint4*)(sa_ + 32 * 64) = P##a1;                                          \
    *(uint4*)(sa_ + 64 * 64) = P##a2;                                          \
    *(uint4*)(sa_ + 96 * 64) = P##a3;                                          \
    *(uint4*)(sb_) = P##b0;                                                    \
    *(uint4*)(sb_ + 32 * 64) = P##b1;                                          \
    *(uint4*)(sb_ + 64 * 64) = P##b2;                                          \
    *(uint4*)(sb_ + 96 * 64) = P##b3;                                          \
  }
#define COMPUTE(buf)                                                           \
  {                                                                            \
    const u16* c1_ = s1 + (buf) * 16384;                                       \
    const u16* c2_ = s2 + (buf) * 16384;                                       \
    _Pragma("unroll") for (int s = 0; s < 2; ++s) {                            \
      bf16x8 f1[4], f2[4];                                                     \
      const int sw_ = ((4 * s + g) ^ (fr >> 1)) << 3;                          \
      _Pragma("unroll") for (int i = 0; i < 4; ++i) {                          \
        f1[i] = *(const bf16x8*)(c1_ + (w1 + i * 16 + fr) * 64 + sw_);         \
        f2[i] = *(const bf16x8*)(c2_ + (w2 + i * 16 + fr) * 64 + sw_);         \
      }                                                                        \
      _Pragma("unroll") for (int i = 0; i < 4; ++i)                            \
        _Pragma("unroll") for (int j = 0; j < 4; ++j) acc[i][j] = mfma16(f1[i], f2[j], acc[i][j]); \
    }                                                                          \
  }
#define TM_OF(t) (MODE == 0 ? ((t) < 3168 ? ((t) % 1056) / 8 : ((t) - 3168) / 6) : (t) / ntn)
#define TN_OF(t) (MODE == 0 ? ((t) < 3168 ? ((t) / 1056) * 8 + ((t) & 7) : 24 + ((t) - 3168) % 6) : (t) % ntn)
  int t0 = tb0;
  int t = TILE_OF(t0);
  bool have = t < ntiles;
  if (have) {
    aptr = A + (size_t)(TM_OF(t) * 128 + lrow) * lda + lseg * 8;
    bptr = Bt + (size_t)(TN_OF(t) * 128 + lrow) * 1024 + lseg * 8;
    GLOAD(x, KT0);
    GLOAD(y, KT0 + 1);
  }
  while (have) {
    const int tn = TN_OF(t), tm = TM_OF(t);
    const int m0 = tm * 128, n0 = tn * 128;
    bool TR = TRfix;
    if (MODE == 0) TR = !((tn >= 6 && tn < 9) || tn == 18);
    const u16* s1 = TR ? sB : sA;
    const u16* s2 = TR ? sA : sB;
    const int w1 = (TR ? wn : wm) * 64, w2 = (TR ? wm : wn) * 64;

    f32x4 acc[4][4];
#pragma unroll
    for (int i = 0; i < 4; ++i)
#pragma unroll
      for (int j = 0; j < 4; ++j) acc[i][j] = f32x4{0.f, 0.f, 0.f, 0.f};

    __syncthreads();
    SSTORE(x, 0);
    GLOAD(x, KT0 + 2);
    __syncthreads();
#pragma unroll 1
    for (int kt = 0; kt < NKT; kt += 2) {
      SSTORE(y, 1);
      if (kt + 3 < NKT) GLOAD(y, KT0 + kt + 3);
      COMPUTE(0);
      __syncthreads();
      if (kt + 2 < NKT) SSTORE(x, 0);
      if (kt + 4 < NKT) GLOAD(x, KT0 + kt + 4);
      COMPUTE(1);
      __syncthreads();
    }
    t0 += tbs;
    const int tnext = TILE_OF(t0);
    const bool havenext = tnext < ntiles;
    if (havenext) {
      aptr = A + (size_t)(TM_OF(tnext) * 128 + lrow) * lda + lseg * 8;
      bptr = Bt + (size_t)(TN_OF(tnext) * 128 + lrow) * 1024 + lseg * 8;
      GLOAD(x, KT0);
      GLOAD(y, KT0 + 1);
    }

    if (MODE != 0) {
      const float* mod = (const float*)(p.ws + OFF_MOD) + (size_t)l * 3 * 3072;
#pragma unroll
      for (int b2 = 0; b2 < 4; ++b2) {
        const int m = m0 + wm * 64 + b2 * 16 + fr;
        const int bi = m < 8192 ? 0 : (m < ML ? 1 : 2);
        const float* src;
        float* dst;
        if (m < ML) {
          src = ((MODE == 2 && l == 0) ? p.x : p.out) + (size_t)m * 1024;
          dst = p.out + (size_t)m * 1024;
        } else {
          src = ((MODE == 2 && l == 0) ? p.ctx : (const float*)(p.ws + OFF_XC)) + (size_t)(m - ML) * 1024;
          dst = (float*)(p.ws + OFF_XC) + (size_t)(m - ML) * 1024;
        }
#pragma unroll
        for (int a = 0; a < 4; ++a) {
          const int n = n0 + wn * 64 + a * 16 + 4 * g;
          float4 xo = *(const float4*)(src + n);
          float4 gt = *(const float4*)(mod + bi * 3072 + 2048 + n);
          float4 o;
          o.x = xo.x + gt.x * acc[a][b2][0];
          o.y = xo.y + gt.y * acc[a][b2][1];
          o.z = xo.z + gt.z * acc[a][b2][2];
          o.w = xo.w + gt.w * acc[a][b2][3];
          *(float4*)(dst + n) = o;
        }
      }
    } else {
      const int nbase = n0 + wn * 64;
      if (!TR) {
        if (tn == 18) {
#pragma unroll
          for (int mt = 0; mt < 4; ++mt) {
            const int mb = m0 + wm * 64 + mt * 16 + 4 * g;
#pragma unroll
            for (int nt = 0; nt < 4; ++nt) {
              const int hc = nbase - 2304 + nt * 16 + fr;
              const int kvh = hc >> 6, d = hc & 63;
              uint2 pk;
              pk.x = pack2bf(acc[mt][nt][0], acc[mt][nt][1]);
              pk.y = pack2bf(acc[mt][nt][2], acc[mt][nt][3]);
              if (mb < ML) {
                const int b = mb >> 13, tk = mb & 8191;
                u16* dst = (u16*)(p.ws + OFF_VT) + ((size_t)((b * 2 + kvh) * 64 + d)) * 8192 + tk;
                *(uint2*)dst = pk;
              } else {
                const int mm = mb - ML, b = mm >> 8, tk = mm & 255;
                u16* dst = (u16*)(p.ws + OFF_VTC) + ((size_t)((b * 2 + kvh) * 64 + d)) * 256 + tk;
                *(uint2*)dst = pk;
              }
            }
          }
        } else {
#pragma unroll
          for (int mt = 0; mt < 4; ++mt) {
            const int tg = ((m0 + wm * 64 + mt * 16) >> 2) + g;
#pragma unroll
            for (int nt = 0; nt < 4; ++nt) {
              const int hc = nbase - 768 + nt * 16 + fr;
              const int h = hc >> 6, rv = hc & 63;
              h4 hv;
              hv[0] = (_Float16)acc[mt][nt][0];
              hv[1] = (_Float16)acc[mt][nt][1];
              hv[2] = (_Float16)acc[mt][nt][2];
              hv[3] = (_Float16)acc[mt][nt][3];
              *(h4*)(p.ws + OFF_V4 + ((size_t)(tg * 6 + h) * 64 + rv) * 8) = hv;
            }
          }
        }
      } else {
        const int pc = nbase < 768 ? nbase : (nbase < 2304 ? nbase - 384 : nbase - 512);
        const bool rope = (tn >= 14 && tn < 18);
        const float* ropeT = (const float*)(p.ws + OFF_ROPE);
#pragma unroll
        for (int b2 = 0; b2 < 4; ++b2) {
          const int m = m0 + wm * 64 + b2 * 16 + fr;
          if (rope && m < ML) {
            const int tk = m & 8191;
#pragma unroll
            for (int a = 0; a < 2; ++a) {
              const int pos = a == 0 ? (tk >> 6) : (tk & 63);
#pragma unroll
              for (int i = 0; i < 4; ++i) {
                const int f = 4 * g + i;
                const float cs = ropeT[(pos * 16 + f) * 2], sn = ropeT[(pos * 16 + f) * 2 + 1];
                const float t1 = acc[a][b2][i], t2 = acc[a + 2][b2][i];
                acc[a][b2][i] = t1 * cs - t2 * sn;
                acc[a + 2][b2][i] = t1 * sn + t2 * cs;
              }
            }
          }
          if (tn == 12) {
#pragma unroll
            for (int a = 0; a < 4; ++a)
#pragma unroll
              for (int i = 0; i < 4; ++i) acc[a][b2][i] = tanh_f(acc[a][b2][i]);
          }
#pragma unroll
          for (int a = 0; a < 4; ++a) {
            uint2 pk;
            pk.x = pack2bf(acc[a][b2][0], acc[a][b2][1]);
            pk.y = pack2bf(acc[a][b2][2], acc[a][b2][3]);
            *(uint2*)(sA + (wm * 64 + b2 * 16 + fr) * 136 + wn * 64 + a * 16 + 4 * g) = pk;
          }
        }
        __syncthreads();
        {
          const int pc0 = n0 < 768 ? n0 : (n0 < 2304 ? n0 - 384 : n0 - 512);
#pragma unroll
          for (int q = 0; q < 8; ++q) {
            const int c = tid + 256 * q, row = c >> 4, ch = c & 15;
            const uint4 v = *(const uint4*)(sA + row * 136 + ch * 8);
            *(uint4*)(P + (size_t)(m0 + row) * PW + pc0 + ch * 8) = v;
          }
        }
      }
    }
    t = tnext;
    have = havenext;
  }
#undef GLOAD
#undef SSTORE
#undef COMPUTE
#undef ACOL
#undef TILE_OF
#undef TM_OF
#undef TN_OF
}

DEVI void prep_wave_task(const Params& p, int l, int m0, int h, int lane) {
  const int fr = lane & 15, g = lane >> 4;
  const u16* P = (const u16*)(p.ws + OFF_P);
  const u16* Prow = P + (size_t)(m0 + fr) * PW;
  float kf[4][4], rf[4][4], kkv[4][4];
  float kkp[4], kap[4], rkp[4];
#pragma unroll
  for (int nt = 0; nt < 4; ++nt) {
    const int c = h * 64 + nt * 16 + fr;
    kkp[nt] = p.rw_k_k[l * 384 + c];
    kap[nt] = p.rw_k_a[l * 384 + c];
    rkp[nt] = p.rw_r_k[l * 384 + c];
  }
  float ss[4], bs[4];
#pragma unroll
  for (int i = 0; i < 4; ++i) {
    const u16* q = P + (size_t)(m0 + 4 * g + i) * PW;
    ss[i] = 0.f;
    bs[i] = 0.f;
#pragma unroll
    for (int nt = 0; nt < 4; ++nt) {
      const int c = h * 64 + nt * 16 + fr;
      kf[i][nt] = bf2f(q[C_K + c]);
      rf[i][nt] = bf2f(q[C_R + c]);
      const float kr = kf[i][nt] * kkp[nt];
      kkv[i][nt] = kr;
      ss[i] += kr * kr;
      bs[i] += rf[i][nt] * kf[i][nt] * rkp[nt];
    }
    ss[i] = reduce16(ss[i]);
    bs[i] = reduce16(bs[i]);
    const float rn = rsqrtf(fmaxf(ss[i], 1e-12f));
#pragma unroll
    for (int nt = 0; nt < 4; ++nt) kkv[i][nt] *= rn;
    if (fr == 0) ((float*)(p.ws + OFF_BONUS))[(size_t)(m0 + 4 * g + i) * 6 + h] = bs[i];
  }
  const int tg = (m0 >> 2) + g;
#pragma unroll
  for (int nt = 0; nt < 4; ++nt) {
    const int c = nt * 16 + fr;
    unsigned char* base = p.ws + OFF_DI + ((size_t)(tg * 6 + h) * 64 + c) * 16;
    h4 a, b;
#pragma unroll
    for (int i = 0; i < 4; ++i) {
      a[i] = (_Float16)kkv[i][nt];
      b[i] = (_Float16)rf[i][nt];
    }
    *(h4*)base = a;
    *(h4*)(base + 8) = b;
  }
  const u16* LT = (const u16*)(p.ws + OFF_LORA);
#pragma unroll 1
  for (int d = 0; d < 2; ++d) {
    f32x4 accw[4], acca[4];
#pragma unroll
    for (int nt = 0; nt < 4; ++nt) {
      accw[nt] = f32x4{0.f, 0.f, 0.f, 0.f};
      acca[nt] = f32x4{0.f, 0.f, 0.f, 0.f};
    }
#pragma unroll
    for (int s = 0; s < 2; ++s) {
      const bf16x8 aw = *(const bf16x8*)(Prow + C_WD + d * 64 + s * 32 + g * 8);
      const bf16x8 aa = *(const bf16x8*)(Prow + C_AD + d * 64 + s * 32 + g * 8);
#pragma unroll
      for (int nt = 0; nt < 4; ++nt) {
        const size_t rw = (size_t)(h * 64 + nt * 16 + fr) * 64 + s * 32 + g * 8;
        const bf16x8 bw = *(const bf16x8*)(LT + (size_t)((l * 2 + d) * 2 + 0) * 384 * 64 + rw);
        const bf16x8 ba = *(const bf16x8*)(LT + (size_t)((l * 2 + d) * 2 + 1) * 384 * 64 + rw);
        accw[nt] = mfma16(aw, bw, accw[nt]);
        acca[nt] = mfma16(aa, ba, acca[nt]);
      }
    }
#pragma unroll
    for (int nt = 0; nt < 4; ++nt) {
      const int cl = nt * 16 + fr, c = h * 64 + cl;
      const float w0 = p.rw_w0[(l * 2 + d) * 384 + c];
      const float a0 = p.rw_a0[(l * 2 + d) * 384 + c];
      h4 hu, hn, hk;
#pragma unroll
      for (int i = 0; i < 4; ++i) {
        const float sig = sigmoid_f(w0 + accw[nt][i]);
        const float u = 1.f - __expf(-0.60653066f * sig);
        const float av = sigmoid_f(a0 + acca[nt][i]);
        hu[i] = (_Float16)u;
        hn[i] = (_Float16)(-kkv[i][nt] * av);
        hk[i] = (_Float16)(kf[i][nt] * (1.f + (av - 1.f) * kap[nt]));
      }
      unsigned char* base = p.ws + OFF_DD + (size_t)d * SZ_DD1 + ((size_t)(tg * 6 + h) * 64 + cl) * 24;
      *(h4*)base = hu;
      *(h4*)(base + 8) = hn;
      *(h4*)(base + 16) = hk;
    }
  }
}

DEVI void prep_phase(const Params& p, int l, unsigned char* smem) {
  const int tid = TIDX, lane = tid & 63;
  const int bid = BIDX;
  u16* P = (u16*)(p.ws + OFF_P);
  const int gw = bid * 4 + (tid >> 6), nw = (int)gridDim.x * 4;
  for (int wt = gw; wt < (MT / 16) * 6; wt += nw) prep_wave_task(p, l, (wt / 6) * 16, wt % 6, lane);
#pragma unroll 1
  for (int item = bid * 256 + tid; item < MT * 32; item += (int)gridDim.x * 256) {
      const int m = item >> 5, ch = (item & 31) * 8;
      int pos, last;
      if (m < ML) { pos = m & 8191; last = 8191; } else { pos = (m - ML) & 255; last = 255; }
      const u16* row = P + (size_t)m * PW;
      float uc[8], up[8], un[8];
      {
        bf16x8 a = *(const bf16x8*)(row + C_CG + ch), b = *(const bf16x8*)(row + C_XIN + ch);
#pragma unroll
        for (int e = 0; e < 8; ++e) uc[e] = bf2f((u16)a[e]) * bf2f((u16)b[e]);
      }
      if (pos > 0) {
        bf16x8 a = *(const bf16x8*)(row - PW + C_CG + ch), b = *(const bf16x8*)(row - PW + C_XIN + ch);
#pragma unroll
        for (int e = 0; e < 8; ++e) up[e] = bf2f((u16)a[e]) * bf2f((u16)b[e]);
      } else {
#pragma unroll
        for (int e = 0; e < 8; ++e) up[e] = 0.f;
      }
      if (pos < last) {
        bf16x8 a = *(const bf16x8*)(row + PW + C_CG + ch), b = *(const bf16x8*)(row + PW + C_XIN + ch);
#pragma unroll
        for (int e = 0; e < 8; ++e) un[e] = bf2f((u16)a[e]) * bf2f((u16)b[e]);
      } else {
#pragma unroll
        for (int e = 0; e < 8; ++e) un[e] = 0.f;
      }
      bf16x8 bg = *(const bf16x8*)(row + C_BG + ch), gc = *(const bf16x8*)(row + C_GCV + ch);
      const float* cw = p.cv_w + l * 768;
      unsigned o[4];
#pragma unroll
      for (int e = 0; e < 8; e += 2) {
        float y0 = up[e] * cw[ch + e] + uc[e] * cw[256 + ch + e] + un[e] * cw[512 + ch + e];
        float y1 = up[e + 1] * cw[ch + e + 1] + uc[e + 1] * cw[256 + ch + e + 1] + un[e + 1] * cw[512 + ch + e + 1];
        y0 = bf2f((u16)bg[e]) * y0 * silu_f(bf2f((u16)gc[e]));
        y1 = bf2f((u16)bg[e + 1]) * y1 * silu_f(bf2f((u16)gc[e + 1]));
        o[e >> 1] = pack2bf(y0, y1);
      }
      *(uint4*)(P + (size_t)m * PW + C_BG + ch) = uint4{o[0], o[1], o[2], o[3]};
  }
}

constexpr int CHUNK_B = 20992;
#define SCAN_RED_HEAD(OS)                                                                                     \
  "v_fma_mix_f32 %[pp], %[kk0], %[S0], 0 op_sel:[" OS ",0,0] op_sel_hi:[1,0,0]\n\t"                           \
  "v_fma_mix_f32 %[pp], %[kk1], %[S1], %[pp] op_sel:[" OS ",0,0] op_sel_hi:[1,0,0]\n\t"                       \
  "v_fma_mix_f32 %[T0], -%[u0], %[S0], %[S0] op_sel:[" OS ",0,0] op_sel_hi:[1,0,0]\n\t"                       \
  "v_fma_mix_f32 %[T1], -%[u1], %[S1], %[S1] op_sel:[" OS ",0,0] op_sel_hi:[1,0,0]\n\t"                       \
  "v_add_f32_dpp %[pp], %[pp], %[pp] quad_perm:[1,0,3,2] row_mask:0xf bank_mask:0xf bound_ctrl:1\n\t"         \
  "v_fma_mix_f32 %[T0], %[vd], %[kd0], %[T0] op_sel:[" OS "," OS ",0] op_sel_hi:[1,1,0]\n\t"                  \
  "v_fma_mix_f32 %[T1], %[vd], %[kd1], %[T1] op_sel:[" OS "," OS ",0] op_sel_hi:[1,1,0]\n\t"                  \
  "v_add_f32_dpp %[pp], %[pp], %[pp] quad_perm:[2,3,0,1] row_mask:0xf bank_mask:0xf bound_ctrl:1\n\t"
#define SCAN_RED_TAIL(OS)                                                                                     \
  "v_add_f32_dpp %[pp], %[pp], %[pp] row_half_mirror row_mask:0xf bank_mask:0xf bound_ctrl:1\n\t"             \
  "s_nop 1\n\t"                                                                                               \
  "v_add_f32_dpp %[pp], %[pp], %[pp] row_mirror row_mask:0xf bank_mask:0xf bound_ctrl:1\n\t"                  \
  "v_mov_b32 %[tmp], %[pp]\n\t"                                                                               \
  "s_nop 1\n\t"                                                                                               \
  "v_permlane16_swap_b32 %[pp], %[tmp]\n\t"                                                                   \
  "v_add_f32 %[pp], %[pp], %[tmp]\n\t"                                                                        \
  "v_fma_mix_f32 %[S0], %[nk0], %[pp], %[T0] op_sel:[" OS ",0,0] op_sel_hi:[1,0,0]\n\t"                       \
  "v_fma_mix_f32 %[S1], %[nk1], %[pp], %[T1] op_sel:[" OS ",0,0] op_sel_hi:[1,0,0]\n\t"
#define SCAN_PY(OS, Y)                                                                                        \
  "v_fma_mix_f32 %[" Y "], %[r0], %[S0], 0 op_sel:[" OS ",0,0] op_sel_hi:[1,0,0]\n\t"                         \
  "v_fma_mix_f32 %[" Y "], %[r1], %[S1], %[" Y "] op_sel:[" OS ",0,0] op_sel_hi:[1,0,0]\n\t"
#define SCAN_PY_LAST(OS, Y)                                                                                   \
  "v_fma_mix_f32 %[" Y "], %[r0], %[S0], 0 op_sel:[" OS ",0,0] op_sel_hi:[1,0,0]\n\t"                         \
  "v_fma_mix_f32 %[" Y "], %[r1], %[S1], %[" Y "] op_sel:[" OS ",0,0] op_sel_hi:[1,0,0]"
#define SCAN_PAIR_ASM(OSA, OSB)                                                                               \
  SCAN_RED_HEAD(OSA) "s_nop 1\n\t" SCAN_RED_TAIL(OSA)                                                         \
  SCAN_RED_HEAD(OSB) SCAN_PY(OSA, "ya") SCAN_RED_TAIL(OSB)                                                    \
  SCAN_PY_LAST(OSB, "yb")
#define DPPQ "row_mask:0xf bank_mask:0xf bound_ctrl:1\n\t"
#define SCAN_TAIL_W(OS, N1, N2)                                                                               \
  "v_add_f32_dpp %[pp], %[pp], %[pp] row_half_mirror " DPPQ N1                                               \
  "v_add_f32_dpp %[pp], %[pp], %[pp] row_mirror " DPPQ                                                       \
  "v_mov_b32 %[tmp], %[pp]\n\t" N2                                                                            \
  "v_permlane16_swap_b32 %[pp], %[tmp]\n\t"                                                                   \
  "v_add_f32 %[pp], %[pp], %[tmp]\n\t"                                                                        \
  "v_fma_mix_f32 %[S0], %[nk0], %[pp], %[T0] op_sel:[" OS ",0,0] op_sel_hi:[1,0,0]\n\t"                       \
  "v_fma_mix_f32 %[S1], %[nk1], %[pp], %[T1] op_sel:[" OS ",0,0] op_sel_hi:[1,0,0]\n\t"
#define R1_2  "v_cndmask_b32_e64 %[t1], %[a1], %[a0], %[m0]\n\t" "v_cndmask_b32_e64 %[t3], %[a3], %[a2], %[m0]\n\t"
#define R3_4  "v_cndmask_b32_e64 %[t0], %[a0], %[a1], %[m0]\n\t" "v_cndmask_b32_e64 %[t2], %[a2], %[a3], %[m0]\n\t"
#define R5_6  "v_add_f32_dpp %[t0], %[t1], %[t0] quad_perm:[1,0,3,2] " DPPQ "v_add_f32_dpp %[t2], %[t3], %[t2] quad_perm:[1,0,3,2] " DPPQ
#define R7_8  "v_cndmask_b32_e64 %[t3], %[t2], %[t0], %[m1]\n\t" "v_cndmask_b32_e64 %[t1], %[t0], %[t2], %[m1]\n\t"
#define R9    "v_add_f32_dpp %[t1], %[t3], %[t1] quad_perm:[2,3,0,1] " DPPQ "s_nop 0\n\t"
#define R10   "v_add_f32_dpp %[t1], %[t1], %[t1] row_ror:4 " DPPQ "s_nop 0\n\t"
#define R11   "v_add_f32_dpp %[t1], %[t1], %[t1] row_ror:8 " DPPQ "s_nop 0\n\t"
#define R12   "v_mov_b32 %[t3], %[t1]\n\t" "s_nop 0\n\t"
#define R13_14 "v_permlane16_swap_b32 %[t1], %[t3]\n\t" "v_add_f32 %[t1], %[t1], %[t3]\n\t"
#define SCAN_PAIR1_ASM(OSA, OSB)                                                                              \
  SCAN_RED_HEAD(OSA) R1_2 SCAN_TAIL_W(OSA, R3_4, R5_6)                                                        \
  SCAN_RED_HEAD(OSB) SCAN_PY(OSA, "ya") SCAN_TAIL_W(OSB, R7_8, R9)                                            \
  SCAN_PY_LAST(OSB, "yb")
#define SCAN_PAIR2_ASM(OSA, OSB)                                                                              \
  SCAN_RED_HEAD(OSA) R10 SCAN_TAIL_W(OSA, R11, R12)                                                           \
  SCAN_RED_HEAD(OSB) SCAN_PY(OSA, "ya") SCAN_TAIL_W(OSB, R13_14, "s_nop 1\n\t")                               \
  SCAN_PY_LAST(OSB, "yb")
template <int FIRST>
DEVI void scan_pair(float& S0, float& S1, float& ya, float& yb, unsigned kk0, unsigned r0, unsigned kk1, unsigned r1,
                    unsigned u0, unsigned nk0, unsigned kd0, unsigned u1, unsigned nk1, unsigned kd1, unsigned vd) {
  float pp, tmp, T0, T1;
  if (FIRST)
    asm(SCAN_PAIR_ASM("1", "0")
        : [S0] "+v"(S0), [S1] "+v"(S1), [ya] "=&v"(ya), [yb] "=&v"(yb), [pp] "=&v"(pp), [tmp] "=&v"(tmp),
          [T0] "=&v"(T0), [T1] "=&v"(T1)
        : [kk0] "v"(kk0), [kk1] "v"(kk1), [u0] "v"(u0), [u1] "v"(u1), [vd] "v"(vd), [kd0] "v"(kd0), [kd1] "v"(kd1),
          [nk0] "v"(nk0), [nk1] "v"(nk1), [r0] "v"(r0), [r1] "v"(r1));
  else
    asm(SCAN_PAIR_ASM("0", "1")
        : [S0] "+v"(S0), [S1] "+v"(S1), [ya] "=&v"(ya), [yb] "=&v"(yb), [pp] "=&v"(pp), [tmp] "=&v"(tmp),
          [T0] "=&v"(T0), [T1] "=&v"(T1)
        : [kk0] "v"(kk0), [kk1] "v"(kk1), [u0] "v"(u0), [u1] "v"(u1), [vd] "v"(vd), [kd0] "v"(kd0), [kd1] "v"(kd1),
          [nk0] "v"(nk0), [nk1] "v"(nk1), [r0] "v"(r0), [r1] "v"(r1));
}
#define PAIR_IO [S0] "+v"(S0), [S1] "+v"(S1), [ya] "=&v"(ya), [yb] "=&v"(yb), [pp] "=&v"(pp), [tmp] "=&v"(tmp), [T0] "=&v"(T0), [T1] "=&v"(T1)
#define PAIR_IN [kk0] "v"(kk0), [kk1] "v"(kk1), [u0] "v"(u0), [u1] "v"(u1), [vd] "v"(vd), [kd0] "v"(kd0), [kd1] "v"(kd1), [nk0] "v"(nk0), [nk1] "v"(nk1), [r0] "v"(r0), [r1] "v"(r1)
template <int FIRST>
DEVI void scan_pair1(float& S0, float& S1, float& ya, float& yb, float& t1, float a0, float a1, float a2, float a3,
                     unsigned long long m0, unsigned long long m1, unsigned kk0, unsigned r0, unsigned kk1, unsigned r1,
                     unsigned u0, unsigned nk0, unsigned kd0, unsigned u1, unsigned nk1, unsigned kd1, unsigned vd) {
  float pp, tmp, T0, T1, t0, t2, t3;
  if (FIRST)
    asm(SCAN_PAIR1_ASM("1", "0")
        : PAIR_IO, [t0] "=&v"(t0), [t1] "=&v"(t1), [t2] "=&v"(t2), [t3] "=&v"(t3)
        : PAIR_IN, [a0] "v"(a0), [a1] "v"(a1), [a2] "v"(a2), [a3] "v"(a3), [m0] "s"(m0), [m1] "s"(m1));
  else
    asm(SCAN_PAIR1_ASM("0", "1")
        : PAIR_IO, [t0] "=&v"(t0), [t1] "=&v"(t1), [t2] "=&v"(t2), [t3] "=&v"(t3)
        : PAIR_IN, [a0] "v"(a0), [a1] "v"(a1), [a2] "v"(a2), [a3] "v"(a3), [m0] "s"(m0), [m1] "s"(m1));
}
template <int FIRST>
DEVI void scan_pair2(float& S0, float& S1, float& ya, float& yb, float& t1, unsigned kk0, unsigned r0, unsigned kk1,
                     unsigned r1, unsigned u0, unsigned nk0, unsigned kd0, unsigned u1, unsigned nk1, unsigned kd1,
                     unsigned vd) {
  float pp, tmp, T0, T1, t3;
  if (FIRST)
    asm(SCAN_PAIR2_ASM("1", "0") : PAIR_IO, [t1] "+v"(t1), [t3] "=&v"(t3) : PAIR_IN);
  else
    asm(SCAN_PAIR2_ASM("0", "1") : PAIR_IO, [t1] "+v"(t1), [t3] "=&v"(t3) : PAIR_IN);
}

DEVI float treduce4_asm(float a0, float a1, float a2, float a3, unsigned long long m0, unsigned long long m1) {
  float t0, t1, t2, t3;
  asm("v_cndmask_b32_e64 %[t1], %[a1], %[a0], %[m0]\n\t"
      "v_cndmask_b32_e64 %[t3], %[a3], %[a2], %[m0]\n\t"
      "v_cndmask_b32_e64 %[t0], %[a0], %[a1], %[m0]\n\t"
      "v_cndmask_b32_e64 %[t2], %[a2], %[a3], %[m0]\n\t"
      "v_add_f32_dpp %[t0], %[t1], %[t0] quad_perm:[1,0,3,2] row_mask:0xf bank_mask:0xf bound_ctrl:1\n\t"
      "v_add_f32_dpp %[t2], %[t3], %[t2] quad_perm:[1,0,3,2] row_mask:0xf bank_mask:0xf bound_ctrl:1\n\t"
      "s_nop 0\n\t"
      "v_cndmask_b32_e64 %[t3], %[t2], %[t0], %[m1]\n\t"
      "v_cndmask_b32_e64 %[t1], %[t0], %[t2], %[m1]\n\t"
      "s_nop 0\n\t"
      "v_add_f32_dpp %[t1], %[t3], %[t1] quad_perm:[2,3,0,1] row_mask:0xf bank_mask:0xf bound_ctrl:1\n\t"
      "s_nop 1\n\t"
      "v_add_f32_dpp %[t1], %[t1], %[t1] row_ror:4 row_mask:0xf bank_mask:0xf bound_ctrl:1\n\t"
      "s_nop 1\n\t"
      "v_add_f32_dpp %[t1], %[t1], %[t1] row_ror:8 row_mask:0xf bank_mask:0xf bound_ctrl:1\n\t"
      "v_mov_b32 %[t3], %[t1]\n\t"
      "s_nop 1\n\t"
      "v_permlane16_swap_b32 %[t1], %[t3]\n\t"
      "v_add_f32 %[t1], %[t1], %[t3]\n\t"
      "s_nop 0"
      : [t0] "=&v"(t0), [t1] "=&v"(t1), [t2] "=&v"(t2), [t3] "=&v"(t3)
      : [a0] "v"(a0), [a1] "v"(a1), [a2] "v"(a2), [a3] "v"(a3), [m0] "s"(m0), [m1] "s"(m1));
  return t1;
}

template <int DIR>
DEVI void scan_chain(const Params& p, int b, int h, int blk8, int wave, int lane, int tid, unsigned char* smem) {
  const int rs = lane >> 5, kp = lane & 31;
  const int row = blk8 * 8 + wave * 2 + rs;
  const unsigned char* base = p.ws + OFF_DI;
  float* yacc = (float*)(p.ws + OFF_P + (DIR ? (size_t)C_CG * 2 : 0)) + h * 64 + row;
  constexpr int SG = DIR ? -1 : 1;
#define TG0(chunk) ((chunk) < 8 ? 4096 + b * 64 + (DIR ? 63 - (chunk) * 8 : (chunk) * 8)                     \
                                : b * 2048 + (DIR ? 2047 - ((chunk) * 8 - 64) : ((chunk) * 8 - 64)))
  int C0, C1, C2, C3, C4, S0s, S1s, S2s, S3s, S4s;
#define PIECE(q, C, S)                                                                                       \
  {                                                                                                          \
    const int idx_ = tid + 256 * (q);                                                                        \
    const int g_ = idx_ / 160, r_ = idx_ - g_ * 160;                                                         \
    const bool di_ = r_ < 64;                                                                                \
    S = di_ ? 6144 : 9216;                                                                                   \
    C = (di_ ? h * 1024 + r_ * 16 : (int)SZ_DI + DIR * (int)SZ_DD1 + h * 1536 + (r_ - 64) * 16) + SG * g_ * S; \
  }
  PIECE(0, C0, S0s) PIECE(1, C1, S1s) PIECE(2, C2, S2s) PIECE(3, C3, S3s) PIECE(4, C4, S4s)
#undef PIECE
  const int tv = tid & 63;
  const int CV = (int)(SZ_DI + 2 * SZ_DD1) + (h * 64 + blk8 * 8) * 8 + (tv & 7) * 8 + SG * (tv >> 3) * 3072;
  uint4 st0, st1, st2, st3, st4;
  uint2 stv;
#define ISSUE(chunk)                                                                            \
  {                                                                                             \
    const int tg0_ = TG0(chunk);                                                                \
    st0 = *(const uint4*)(base + (unsigned)(C0 + tg0_ * S0s));                                  \
    st1 = *(const uint4*)(base + (unsigned)(C1 + tg0_ * S1s));                                  \
    st2 = *(const uint4*)(base + (unsigned)(C2 + tg0_ * S2s));                                  \
    st3 = *(const uint4*)(base + (unsigned)(C3 + tg0_ * S3s));                                  \
    st4 = *(const uint4*)(base + (unsigned)(C4 + tg0_ * S4s));                                  \
    stv = *(const uint2*)(base + (unsigned)(CV + tg0_ * 3072));                                 \
  }
#define WRITE(buf)                                                                              \
  {                                                                                             \
    unsigned char* d_ = smem + (buf) * CHUNK_B + tid * 16;                                      \
    *(uint4*)(d_) = st0;                                                                        \
    *(uint4*)(d_ + 4096) = st1;                                                                 \
    *(uint4*)(d_ + 8192) = st2;                                                                 \
    *(uint4*)(d_ + 12288) = st3;                                                                \
    *(uint4*)(d_ + 16384) = st4;                                                                \
    *(uint2*)(smem + (buf) * CHUNK_B + 20480 + tv * 8) = stv;                                   \
  }
  float S0 = 0.f, S1 = 0.f;
  const size_t yoff = (size_t)(lane & 3) * (PROWB / 4);
  float* dump = (float*)(p.ws + OFF_DUMP) + (size_t)(blk8 + 8 * (h + 6 * (2 * b + DIR))) * 256 + (tid & 255);
  float pa0 = 0.f, pa1 = 0.f, pa2 = 0.f, pa3 = 0.f;
  float* yprev = dump;
  ISSUE(0);
  WRITE(0);
  ISSUE(1);
  __syncthreads();
#pragma unroll 1
  for (int chunk = 0; chunk < 264; ++chunk) {
    WRITE((chunk + 1) & 1);
    {
      const int cn = chunk + 2 < 264 ? chunk + 2 : 263;
      ISSUE(cn);
    }
    const unsigned char* B = smem + (chunk & 1) * CHUNK_B;
    const unsigned char* Bl = B + kp * 32;
    const unsigned char* Bd = B + 1024 + kp * 48;
    const unsigned char* Bv = B + 20480 + (wave * 2 + rs) * 8;
    float* ydst = yacc + (size_t)(4 * TG0(chunk)) * (PROWB / 4) + yoff;
    ydst = kp < 4 ? ydst : dump;
    const long ystep = kp < 4 ? (long)SG * 4 * (long)(PROWB / 4) : 0;
    uint4 nd0 = *(const uint4*)(Bl), nd1 = *(const uint4*)(Bl + 16);
    uint4 ne0 = *(const uint4*)(Bd), ne1 = *(const uint4*)(Bd + 16), ne2 = *(const uint4*)(Bd + 32);
    uint2 nv = *(const uint2*)(Bv);
#pragma unroll
    for (int g = 0; g < 8; ++g) {
      const uint4 d0 = nd0, d1 = nd1, e0 = ne0, e1 = ne1, e2 = ne2;
      const uint2 vv = nv;
      if (g < 7) {
        nd0 = *(const uint4*)(Bl + (g + 1) * 2560);
        nd1 = *(const uint4*)(Bl + (g + 1) * 2560 + 16);
        ne0 = *(const uint4*)(Bd + (g + 1) * 2560);
        ne1 = *(const uint4*)(Bd + (g + 1) * 2560 + 16);
        ne2 = *(const uint4*)(Bd + (g + 1) * 2560 + 32);
        nv = *(const uint2*)(Bv + (g + 1) * 64);
      }
      float y0, y1, y2, y3, yv;
      const unsigned long long M0 = 0xAAAAAAAAAAAAAAAAull, M1 = 0xCCCCCCCCCCCCCCCCull;
      if (DIR == 0) {
        scan_pair1<0>(S0, S1, y0, y1, yv, pa0, pa1, pa2, pa3, M0, M1, d0.x, d0.z, d1.x, d1.z, e0.x, e0.z, e1.x, e1.z, e2.x, e2.z, vv.x);
        scan_pair2<0>(S0, S1, y2, y3, yv, d0.y, d0.w, d1.y, d1.w, e0.y, e0.w, e1.y, e1.w, e2.y, e2.w, vv.y);
      } else {
        scan_pair1<1>(S0, S1, y3, y2, yv, pa0, pa1, pa2, pa3, M0, M1, d0.y, d0.w, d1.y, d1.w, e0.y, e0.w, e1.y, e1.w, e2.y, e2.w, vv.y);
        scan_pair2<1>(S0, S1, y1, y0, yv, d0.x, d0.z, d1.x, d1.z, e0.x, e0.z, e1.x, e1.z, e2.x, e2.z, vv.x);
      }
      *yprev = yv;
      yprev = ydst + (long)g * ystep;
      pa0 = y0; pa1 = y1; pa2 = y2; pa3 = y3;
    }
    __syncthreads();
  }
  *yprev = treduce4_asm(pa0, pa1, pa2, pa3, 0xAAAAAAAAAAAAAAAAull, 0xCCCCCCCCCCCCCCCCull);
#undef TG0
#undef ISSUE
#undef WRITE
}

DEVI void attn_task(const Params& p, int l, int task, int lane) {
  const int fr = lane & 15, g = lane >> 4;
  u16* P = (u16*)(p.ws + OFF_P);
  const bool isctx = task >= 2048;
  int b, kvh, qt;
  if (!isctx) { qt = task & 511; kvh = (task >> 9) & 1; b = task >> 10; }
  else { const int t2 = task - 2048; qt = t2 & 15; kvh = (t2 >> 4) & 1; b = t2 >> 5; }
  const int q0 = qt * 16;
  const size_t qrow = isctx ? (size_t)(ML + b * 256 + q0 + fr) : (size_t)(b * 8192 + q0 + fr);
  u16* Pq = P + qrow * PW;
  bf16x8 qf[3][2];
#pragma unroll
  for (int hq = 0; hq < 3; ++hq)
#pragma unroll
    for (int s = 0; s < 2; ++s) qf[hq][s] = *(const bf16x8*)(Pq + C_Q + (kvh * 3 + hq) * 64 + s * 32 + g * 8);
  float mrun[3], lpart[3];
  f32x4 O[3][4];
#pragma unroll
  for (int hq = 0; hq < 3; ++hq) {
    mrun[hq] = p.at_sink[l * 6 + kvh * 3 + hq];
    lpart[hq] = g == 0 ? 1.f : 0.f;
#pragma unroll
    for (int dt = 0; dt < 4; ++dt) O[hq][dt] = f32x4{0.f, 0.f, 0.f, 0.f};
  }
  const int nwin = isctx ? 0 : 9;
  const u16* VT = (const u16*)(p.ws + OFF_VT) + (size_t)((b * 2 + kvh) * 64) * 8192;
  const u16* VTC = (const u16*)(p.ws + OFF_VTC) + (size_t)((b * 2 + kvh) * 64) * 256;

#define ATT_LOAD(it_, KF, VF)                                                                              \
  {                                                                                                        \
    const bool win_ = (it_) < nwin;                                                                        \
    const int kb_ = win_ ? (q0 - 128 + 32 * (it_)) : 32 * ((it_) - nwin);                                  \
    _Pragma("unroll") for (int tt = 0; tt < 2; ++tt) {                                                     \
      const int key = kb_ + 16 * tt + fr;                                                                  \
      size_t krow;                                                                                         \
      if (win_) { const int kc = key < 0 ? 0 : (key > 8191 ? 8191 : key); krow = (size_t)(b * 8192 + kc); } \
      else krow = (size_t)(ML + b * 256 + key);                                                            \
      _Pragma("unroll") for (int s = 0; s < 2; ++s)                                                        \
        KF[tt][s] = *(const bf16x8*)(P + krow * PW + C_KX + kvh * 64 + s * 32 + g * 8);                    \
    }                                                                                                      \
    _Pragma("unroll") for (int dt = 0; dt < 4; ++dt) {                                                     \
      const int d = dt * 16 + fr;                                                                          \
      uint2 lo, hi;                                                                                        \
      if (win_) {                                                                                          \
        int k1 = kb_ + 4 * g, k2 = kb_ + 16 + 4 * g;                                                       \
        if (k1 < 0 || k1 > 8188) k1 = 0;                                                                   \
        if (k2 < 0 || k2 > 8188) k2 = 0;                                                                   \
        lo = *(const uint2*)(VT + (size_t)d * 8192 + k1);                                                  \
        hi = *(const uint2*)(VT + (size_t)d * 8192 + k2);                                                  \
      } else {                                                                                             \
        lo = *(const uint2*)(VTC + d * 256 + kb_ + 4 * g);                                                 \
        hi = *(const uint2*)(VTC + d * 256 + kb_ + 16 + 4 * g);                                            \
      }                                                                                                    \
      uint4 cmb = uint4{lo.x, lo.y, hi.x, hi.y};                                                           \
      VF[dt] = __builtin_bit_cast(bf16x8, cmb);                                                            \
    }                                                                                                      \
  }
  const int nit = nwin + 8;
  bf16x8 nkf[2][2], nvf[4];
  ATT_LOAD(0, nkf, nvf);
#pragma unroll 1
  for (int it = 0; it < nit; ++it) {
    const bool win = it < nwin;
    const int kb = win ? (q0 - 128 + 32 * it) : 32 * (it - nwin);
    bf16x8 kf[2][2], vf[4];
#pragma unroll
    for (int tt = 0; tt < 2; ++tt)
#pragma unroll
      for (int s = 0; s < 2; ++s) kf[tt][s] = nkf[tt][s];
#pragma unroll
    for (int dt = 0; dt < 4; ++dt) vf[dt] = nvf[dt];
    {
      const int itn = it + 1 < nit ? it + 1 : it;
      ATT_LOAD(itn, nkf, nvf);
    }
#pragma unroll
    for (int hq = 0; hq < 3; ++hq) {
      f32x4 sa = f32x4{0.f, 0.f, 0.f, 0.f}, sb = f32x4{0.f, 0.f, 0.f, 0.f};
#pragma unroll
      for (int s = 0; s < 2; ++s) {
        sa = mfma16(kf[0][s], qf[hq][s], sa);
        sb = mfma16(kf[1][s], qf[hq][s], sb);
      }
      float sv[8];
#pragma unroll
      for (int i = 0; i < 4; ++i) {
        sv[i] = sa[i] * 0.125f;
        sv[4 + i] = sb[i] * 0.125f;
      }
      if (win) {
        const int qpos = q0 + fr;
#pragma unroll
        for (int i = 0; i < 8; ++i) {
          const int kpos = kb + 4 * g + (i & 3) + (i >> 2) * 16;
          const int df = qpos - kpos;
          const bool ok = kpos >= 0 && kpos < 8192 && df <= 128 && df >= -128;
          if (!ok) sv[i] = -1e30f;
        }
      }
      float tmax = sv[0];
#pragma unroll
      for (int i = 1; i < 8; ++i) tmax = fmaxf(tmax, sv[i]);
      {
        auto r16 = __builtin_amdgcn_permlane16_swap(__float_as_uint(tmax), __float_as_uint(tmax), false, false);
        tmax = fmaxf(__uint_as_float(r16[0]), __uint_as_float(r16[1]));
        auto r32 = __builtin_amdgcn_permlane32_swap(__float_as_uint(tmax), __float_as_uint(tmax), false, false);
        tmax = fmaxf(__uint_as_float(r32[0]), __uint_as_float(r32[1]));
      }
      const float mnew = fmaxf(mrun[hq], tmax);
      const float alpha = __expf(mrun[hq] - mnew);
      mrun[hq] = mnew;
      float ps = 0.f, pv[8];
#pragma unroll
      for (int i = 0; i < 8; ++i) {
        pv[i] = __expf(sv[i] - mnew);
        ps += pv[i];
      }
      lpart[hq] = lpart[hq] * alpha + ps;
      uint4 pk = uint4{pack2bf(pv[0], pv[1]), pack2bf(pv[2], pv[3]), pack2bf(pv[4], pv[5]), pack2bf(pv[6], pv[7])};
      const bf16x8 pf = __builtin_bit_cast(bf16x8, pk);
#pragma unroll
      for (int dt = 0; dt < 4; ++dt) {
        O[hq][dt] *= alpha;
        O[hq][dt] = mfma16(vf[dt], pf, O[hq][dt]);
      }
    }
  }
#pragma unroll
  for (int hq = 0; hq < 3; ++hq) {
    float lt = lpart[hq] + __shfl_xor(lpart[hq], 16);
    lt += __shfl_xor(lt, 32);
    const float inv = 1.f / lt;
#pragma unroll
    for (int dt = 0; dt < 4; ++dt) {
      u16* dst = Pq + C_GA + (kvh * 3 + hq) * 64 + dt * 16 + 4 * g;
      const uint2 gt = *(const uint2*)dst;
      const float g0 = bf2f((u16)(gt.x & 0xffff)), g1 = bf2f((u16)(gt.x >> 16));
      const float g2 = bf2f((u16)(gt.y & 0xffff)), g3 = bf2f((u16)(gt.y >> 16));
      uint2 o;
      o.x = pack2bf(O[hq][dt][0] * inv * silu_f(g0), O[hq][dt][1] * inv * silu_f(g1));
      o.y = pack2bf(O[hq][dt][2] * inv * silu_f(g2), O[hq][dt][3] * inv * silu_f(g3));
      *(uint2*)dst = o;
    }
  }
}

DEVI void mix_phase(const Params& p, int l, unsigned char* smem) {
  const int tid = TIDX, bid = BIDX;
  const int lane = tid & 63, wave = __builtin_amdgcn_readfirstlane(tid >> 6);
  const int G = (int)gridDim.x;
  const bool iso = (G == 512);
  if (bid < SCAN_BLOCKS) {
    const int xcd = bid & 7, idx = bid >> 3;
    const int chain = xcd * 3 + (idx >> 3), blk8 = idx & 7;
    const int dir = chain & 1, h = (chain >> 1) % 6, b = chain / 12;
    if (dir == 0) scan_chain<0>(p, b, h, blk8, wave, lane, tid, smem);
    else scan_chain<1>(p, b, h, blk8, wave, lane, tid, smem);
  } else {
    unsigned* cnt = (unsigned*)(p.ws + OFF_BAR) + XCD_BAR_WORDS + 64 * l;
    const bool attn_blk = !iso || !(bid >= 256 && bid < 256 + SCAN_BLOCKS);
    int ab, nab;
    if (iso) {
      ab = bid < 256 ? bid - SCAN_BLOCKS : bid - 256 - SCAN_BLOCKS + (256 - SCAN_BLOCKS);
      nab = 2 * (256 - SCAN_BLOCKS);
    } else {
      ab = bid - SCAN_BLOCKS;
      nab = G - SCAN_BLOCKS;
    }
    float* tilef = (float*)smem;
    if (attn_blk) {
      const int aw = ab * 4 + wave, naw = nab * 4;
      const int ntask = 2048 + (l < 3 ? 64 : 0);
      for (int t = aw; t < ntask; t += naw) attn_task(p, l, t, lane);
      convert_weight(p.w_out + (size_t)l * 1024 * 1024, 1024, 1024, (u16*)(p.ws + OFF_WOUTT), tilef, ab, nab);
      asm volatile("s_waitcnt vmcnt(0)" ::: "memory");
      __syncthreads();
      if (tid == 0) {
        __builtin_amdgcn_fence(__ATOMIC_RELEASE, "agent");
        asm volatile("s_waitcnt vmcnt(0)" ::: "memory");
        xb_add(cnt, 1u);
      }
    }
    if (!attn_blk) {
      if (l < 3)
        convert_weight(p.w_in + (size_t)(l + 1) * 1024 * 3840, 1024, 3840, (u16*)(p.ws + OFF_WINT), tilef, bid - 256,
                       SCAN_BLOCKS);
      return;
    }
    if (tid == 0) {
      unsigned sp = 0;
      while (xb_ld(cnt) < (unsigned)nab) {
        __builtin_amdgcn_s_sleep(8);
        if (++sp > (1u << 24)) break;
      }
      __builtin_amdgcn_fence(__ATOMIC_ACQUIRE, "agent");
      asm volatile("s_waitcnt vmcnt(0)" ::: "memory");
    }
    __syncthreads();
    gemm_phase<2>(p, l, smem, ab, nab);
    if (l < 3 && !iso)
      convert_weight(p.w_in + (size_t)(l + 1) * 1024 * 3840, 1024, 3840, (u16*)(p.ws + OFF_WINT), tilef, ab, nab);
  }
}

DEVI void post_phase(const Params& p, int l) {
  const int tid = TIDX;
  const int lane = tid & 63, j = lane >> 4, q = lane & 15;
  const int gw = BIDX * 4 + (tid >> 6), nw = gridDim.x * 4;
  const int ntask = ((l < 3 ? MT : ML) / 4) * 6;
  const float* bonus = (const float*)(p.ws + OFF_BONUS);
  for (int it = gw; it < ntask; it += nw) {
    const int tg = it / 6, h = it - tg * 6;
    const int m = tg * 4 + j;
    unsigned char* rowb = p.ws + OFF_P + (size_t)m * PROWB;
    const float4 yf = *(const float4*)(rowb + (h * 64 + 4 * q) * 4);
    const float4 yb = *(const float4*)(rowb + C_CG * 2 + (h * 64 + 4 * q) * 4);
    const float4 lg = *(const float4*)(p.rw_ln_g + l * 384 + h * 64 + 4 * q);
    const float4 lb = *(const float4*)(p.rw_ln_b + l * 384 + h * 64 + 4 * q);
    const unsigned char* v4 = p.ws + OFF_V4 + ((size_t)(tg * 6 + h) * 64 + 4 * q) * 8 + j * 2;
    const float va = (float)(*(const _Float16*)(v4)), vb = (float)(*(const _Float16*)(v4 + 8));
    const float vc = (float)(*(const _Float16*)(v4 + 16)), vd = (float)(*(const _Float16*)(v4 + 24));
    u16* gp = (u16*)rowb + C_G + h * 64 + 4 * q;
    const uint2 gv = *(const uint2*)gp;
    const float bon = bonus[(size_t)m * 6 + h];
    const float y0 = yf.x + yb.x, y1 = yf.y + yb.y, y2 = yf.z + yb.z, y3 = yf.w + yb.w;
    const float mu = reduce16(y0 + y1 + y2 + y3) * (1.f / 64.f);
    const float d0 = y0 - mu, d1 = y1 - mu, d2 = y2 - mu, d3 = y3 - mu;
    const float var = reduce16(d0 * d0 + d1 * d1 + d2 * d2 + d3 * d3) * (1.f / 64.f);
    const float rstd = rsqrtf(var + 64e-5f);
    const float g0 = bf2f((u16)(gv.x & 0xffff)), g1 = bf2f((u16)(gv.x >> 16));
    const float g2 = bf2f((u16)(gv.y & 0xffff)), g3 = bf2f((u16)(gv.y >> 16));
    uint2 o;
    o.x = pack2bf((d0 * rstd * lg.x + lb.x + bon * va) * silu_f(g0), (d1 * rstd * lg.y + lb.y + bon * vb) * silu_f(g1));
    o.y = pack2bf((d2 * rstd * lg.z + lb.z + bon * vc) * silu_f(g2), (d3 * rstd * lg.w + lb.w + bon * vd) * silu_f(g3));
    *(uint2*)gp = o;
  }
}

DEVI void final_phase(const Params& p) {
  const int tid = TIDX;
  const int lane = tid & 63;
  const int gw = BIDX * 4 + (tid >> 6), nw = gridDim.x * 4;
  for (int m = gw; m < ML; m += nw) {
    float* row = p.out + (size_t)m * 1024;
    float4 v[4];
    float ss = 0.f;
#pragma unroll
    for (int i = 0; i < 4; ++i) {
      v[i] = *(const float4*)(row + i * 256 + lane * 4);
      ss += v[i].x * v[i].x + v[i].y * v[i].y + v[i].z * v[i].z + v[i].w * v[i].w;
    }
    ss = wave_sum(ss);
    const float inv = rsqrtf(ss * (1.f / 1024.f) + 1e-6f);
#pragma unroll
    for (int i = 0; i < 4; ++i) {
      const int c0 = i * 256 + lane * 4;
      const float4 g4 = *(const float4*)(p.final_g + c0);
      float4 o;
      o.x = v[i].x * inv * g4.x; o.y = v[i].y * inv * g4.y; o.z = v[i].z * inv * g4.z; o.w = v[i].w * inv * g4.w;
      *(float4*)(row + c0) = o;
    }
  }
}


#ifndef PROBE_PHASE
#define PROBE_PHASE -1
#endif
#define PB_START() if (PROBE_PHASE >= 0) { pb_t0 = wall_clock64(); }
#define PB_END(id) if (PROBE_PHASE == (id)) { pb_acc += (long long)wall_clock64() - pb_t0; }
__global__ void __launch_bounds__(256, 2) mk_kernel(Params p) {
  __shared__ __attribute__((aligned(16))) unsigned char smem[65536];
  __shared__ uint4 xb_words;
  cg::grid_group grid = cg::this_grid();
  long long pb_t0 = 0, pb_acc = 0;
  unsigned* bar = (unsigned*)(p.ws + OFF_BAR);
  if (threadIdx.x == 0) xb_words = make_uint4(0u, 0u, 0u, 0u);
  __syncthreads();
  if (p.ws == nullptr) grid.sync();
  XcdBarrier xb = xcd_barrier_post(bar, (volatile LAS unsigned*)&xb_words);
  PB_START();
  prologue_phase(p, smem);
  xcd_barrier(xb);
  PB_END(0);
#pragma unroll 1
  for (int l = 0; l < 4; ++l) {
    if (PROBE_PHASE == 8) { PB_START(); xcd_barrier(xb); PB_END(8); }
    PB_START();
    norm_phase(p, l);
    xcd_barrier(xb);
    PB_END(1);
    PB_START();
    gemm_phase<0>(p, l, smem, BIDX, (int)gridDim.x);
    xcd_barrier(xb);
    PB_END(2);
    PB_START();
    prep_phase(p, l, smem);
    xcd_barrier(xb);
    PB_END(3);
    PB_START();
    mix_phase(p, l, smem);
    xcd_barrier(xb);
    PB_END(4);
    PB_START();
    post_phase(p, l);
    xcd_barrier(xb);
    PB_END(5);
    PB_START();
    gemm_phase<1>(p, l, smem, BIDX, (int)gridDim.x);
    xcd_barrier(xb);
    PB_END(6);
  }
  final_phase(p);
  if (PROBE_PHASE >= 0) {
    xcd_barrier(xb);
    if (blockIdx.x == 0) {
      long long k = pb_acc / 20;
      if (k > 60000) k = 60000;
      for (int i = threadIdx.x; i < (int)k; i += 256) p.out[i] += 0.125f;
    }
  }
}

extern "C" void kernel_launch(void* const* d_in, const int* in_sizes, int n_in, void* d_out, int out_size,
                              void* d_ws, size_t ws_size, hipStream_t stream) {
  static int grid_blocks = 0;
  if (!grid_blocks) {
    int dev = 0, cus = 0, per_cu = 0;
    (void)hipGetDevice(&dev);
    (void)hipDeviceGetAttribute(&cus, hipDeviceAttributeMultiprocessorCount, dev);
    (void)hipOccupancyMaxActiveBlocksPerMultiprocessor(&per_cu, mk_kernel, 256, 0);
    if (per_cu > 2) per_cu = 2;
    if (per_cu < 1) per_cu = 1;
    grid_blocks = cus * per_cu;
  }
  Params p{};
  const float** pp = (const float**)&p;
  for (int i = 0; i < 21; ++i) pp[i] = (const float*)d_in[i];
  p.out = (float*)d_out;
  p.ws = (unsigned char*)d_ws;
  (void)hipMemsetAsync((unsigned char*)d_ws + OFF_BAR, 0, (XCD_BAR_WORDS + 256) * 4, stream);
  void* args[] = {&p};
  hipError_t e = hipLaunchCooperativeKernel((void*)mk_kernel, dim3(grid_blocks), dim3(256), args, 0, stream);
  if (e != hipSuccess) fprintf(stderr, "coop launch failed: %s (grid %d)\n", hipGetErrorString(e), grid_blocks);
}
```

```cpp
#include <hip/hip_runtime.h>
#include <hip/hip_bf16.h>
#include <hip/hip_cooperative_groups.h>
#include <cstdio>
namespace cg = cooperative_groups;

typedef unsigned short u16;
typedef __attribute__((ext_vector_type(8))) short bf16x8;
typedef __attribute__((ext_vector_type(4))) float f32x4;
typedef _Float16 h8 __attribute__((ext_vector_type(8)));
typedef _Float16 h4 __attribute__((ext_vector_type(4)));

#define DEVI __device__ __forceinline__

constexpr int PW = 3328;
constexpr size_t PROWB = 6656;
constexpr int MT = 16896;
constexpr int ML = 16384;
constexpr int C_R = 0, C_K = 384, C_G = 768, C_WD = 1152, C_AD = 1280, C_Q = 1408, C_KX = 1792,
              C_GA = 1920, C_BG = 2304, C_CG = 2560, C_XIN = 2816, C_GCV = 3072;
constexpr size_t OFF_P = 0;
constexpr size_t OFF_DI = 112459776;
constexpr size_t SZ_DI = 25952256;
constexpr size_t OFF_DD = OFF_DI + SZ_DI;
constexpr size_t SZ_DD1 = 38928384;
constexpr size_t OFF_V4 = OFF_DD + 2 * SZ_DD1;
constexpr size_t OFF_H = OFF_DI;
constexpr size_t OFF_WINT = OFF_DI + 116785152;
constexpr size_t OFF_WOUTT = OFF_WINT + 7864320;
constexpr size_t OFF_LORA = OFF_WOUTT + 2097152;
constexpr size_t OFF_MOD = OFF_LORA + 786432;
constexpr size_t OFF_XC = OFF_MOD + 147456;
constexpr size_t OFF_ROPE = OFF_XC + 2097152;
constexpr size_t OFF_VT = OFF_ROPE + 16384;
constexpr size_t OFF_VTC = OFF_VT + 4194304;
constexpr size_t OFF_BONUS = OFF_VTC + 131072;
constexpr size_t OFF_BAR = OFF_BONUS + 405504;
constexpr size_t OFF_DUMP = OFF_BAR + 16384;

constexpr int SCAN_BLOCKS = 192;

struct Params {
  const float *x, *c, *ctx, *c_ctx, *w_ada, *b_ada, *norm_g, *w_in, *w_out, *rw_w0, *rw_w_up, *rw_a0,
      *rw_a_up, *rw_k_k, *rw_k_a, *rw_r_k, *rw_ln_g, *rw_ln_b, *at_sink, *cv_w, *final_g;
  float* out;
  unsigned char* ws;
};

typedef __bf16 bf2_t __attribute__((ext_vector_type(2)));
typedef float f2_t __attribute__((ext_vector_type(2)));
DEVI unsigned pack2bf(float a, float b) {
  f2_t v = {a, b};
  return __builtin_bit_cast(unsigned, __builtin_convertvector(v, bf2_t));
}
DEVI u16 f2bf(float f) { return (u16)(pack2bf(f, 0.f) & 0xffffu); }
DEVI float bf2f(u16 h) { return __uint_as_float(((unsigned)h) << 16); }
DEVI float sigmoid_f(float x) { return 1.f / (1.f + __expf(-x)); }
DEVI float silu_f(float x) { return x / (1.f + __expf(-x)); }
DEVI float tanh_f(float x) { return 1.f - 2.f / (1.f + __expf(2.f * x)); }
DEVI f32x4 mfma16(bf16x8 a, bf16x8 b, f32x4 c) { return __builtin_amdgcn_mfma_f32_16x16x32_bf16(a, b, c, 0, 0, 0); }

DEVI int opaque_v(int x) { asm volatile("" : "+v"(x)); return x; }
DEVI int opaque_s(int x) { asm volatile("" : "+s"(x)); return x; }
#define TIDX opaque_v((int)threadIdx.x)
#define BIDX opaque_s((int)blockIdx.x)

template <int CTRL>
DEVI float dppf(float x) {
  return __int_as_float(__builtin_amdgcn_update_dpp(0, __float_as_int(x), CTRL, 0xF, 0xF, true));
}
DEVI float reduce32(float x) {
  x += dppf<0xB1>(x);
  x += dppf<0x4E>(x);
  x += dppf<0x141>(x);
  x += dppf<0x140>(x);
  auto r = __builtin_amdgcn_permlane16_swap(__float_as_uint(x), __float_as_uint(x), false, false);
  return __uint_as_float(r[0]) + __uint_as_float(r[1]);
}
template <int HS> DEVI float mixA(unsigned h, float b) {
  float d;
  if (HS) asm("v_fma_mix_f32 %0, %1, %2, 0 op_sel:[1,0,0] op_sel_hi:[1,0,0]" : "=v"(d) : "v"(h), "v"(b));
  else asm("v_fma_mix_f32 %0, %1, %2, 0 op_sel:[0,0,0] op_sel_hi:[1,0,0]" : "=v"(d) : "v"(h), "v"(b));
  return d;
}
template <int HS> DEVI float mixB(unsigned h, float b, float c) {
  float d;
  if (HS) asm("v_fma_mix_f32 %0, %1, %2, %3 op_sel:[1,0,0] op_sel_hi:[1,0,0]" : "=v"(d) : "v"(h), "v"(b), "v"(c));
  else asm("v_fma_mix_f32 %0, %1, %2, %3 op_sel:[0,0,0] op_sel_hi:[1,0,0]" : "=v"(d) : "v"(h), "v"(b), "v"(c));
  return d;
}
template <int HS> DEVI float mixBn(unsigned h, float b, float c) {
  float d;
  if (HS) asm("v_fma_mix_f32 %0, %1, %2, %3 op_sel:[1,0,0] op_sel_hi:[1,0,0]\n\ts_nop 1" : "=v"(d) : "v"(h), "v"(b), "v"(c));
  else asm("v_fma_mix_f32 %0, %1, %2, %3 op_sel:[0,0,0] op_sel_hi:[1,0,0]\n\ts_nop 1" : "=v"(d) : "v"(h), "v"(b), "v"(c));
  return d;
}
template <int HS> DEVI float mixC(unsigned h, float b, float c) {
  float d;
  if (HS) asm("v_fma_mix_f32 %0, -%1, %2, %3 op_sel:[1,0,0] op_sel_hi:[1,0,0]" : "=v"(d) : "v"(h), "v"(b), "v"(c));
  else asm("v_fma_mix_f32 %0, -%1, %2, %3 op_sel:[0,0,0] op_sel_hi:[1,0,0]" : "=v"(d) : "v"(h), "v"(b), "v"(c));
  return d;
}
template <int HS> DEVI float mixD(unsigned h1, unsigned h2, float c) {
  float d;
  if (HS) asm("v_fma_mix_f32 %0, %1, %2, %3 op_sel:[1,1,0] op_sel_hi:[1,1,0]" : "=v"(d) : "v"(h1), "v"(h2), "v"(c));
  else asm("v_fma_mix_f32 %0, %1, %2, %3 op_sel:[0,0,0] op_sel_hi:[1,1,0]" : "=v"(d) : "v"(h1), "v"(h2), "v"(c));
  return d;
}
DEVI float reduce16(float x) {
  x += dppf<0xB1>(x);
  x += dppf<0x4E>(x);
  x += dppf<0x141>(x);
  x += dppf<0x140>(x);
  return x;
}

template <int HS> DEVI float mixAn(unsigned h, float b) {
  float d;
  if (HS) asm("v_fma_mix_f32 %0, %1, %2, 0 op_sel:[1,0,0] op_sel_hi:[1,0,0]\n\ts_nop 1" : "=v"(d) : "v"(h), "v"(b));
  else asm("v_fma_mix_f32 %0, %1, %2, 0 op_sel:[0,0,0] op_sel_hi:[1,0,0]\n\ts_nop 1" : "=v"(d) : "v"(h), "v"(b));
  return d;
}
template <int HS> DEVI float mixBs(unsigned h, float bs, float c) {
  float d;
  if (HS) asm("v_fma_mix_f32 %0, %1, %2, %3 op_sel:[1,0,0] op_sel_hi:[1,0,0]" : "=v"(d) : "v"(h), "s"(bs), "v"(c));
  else asm("v_fma_mix_f32 %0, %1, %2, %3 op_sel:[0,0,0] op_sel_hi:[1,0,0]" : "=v"(d) : "v"(h), "s"(bs), "v"(c));
  return d;
}
template <int CTRL, int RM>
DEVI float dppf_rm(float x) {
  return __int_as_float(__builtin_amdgcn_update_dpp(0, __float_as_int(x), CTRL, RM, 0xF, false));
}
DEVI float reduce64_hi(float x) {
  x += dppf<0xB1>(x);
  x += dppf<0x4E>(x);
  x += dppf<0x141>(x);
  x += dppf<0x140>(x);
  x += dppf_rm<0x142, 0xA>(x);
  x += dppf_rm<0x143, 0xC>(x);
  return x;
}

DEVI float wave_sum(float x) {
  x = reduce64_hi(x);
  return __int_as_float(__builtin_amdgcn_readlane(__float_as_int(x), 63));
}

#define XB_TMO      128
#define XB_XCNT(j)  (256  + 64 * (j))
#define XB_XSUB(j)  (1280 + 64 * (j))
#define XB_XGEN(j)  (2304 + 64 * (j))
#define XB_TOP      3328
#define XB_TOPGEN   3392
#define XCD_BAR_WORDS 3456
#define XB_SPIN_CAP (1u << 22)
#define LAS __attribute__((address_space(3)))
DEVI unsigned xb_ld(unsigned* p) { return __hip_atomic_load(p, __ATOMIC_RELAXED, __HIP_MEMORY_SCOPE_AGENT); }
DEVI unsigned xb_add(unsigned* p, unsigned v) { return __hip_atomic_fetch_add(p, v, __ATOMIC_RELAXED, __HIP_MEMORY_SCOPE_AGENT); }
DEVI unsigned xb_xcc_id() { return (unsigned)__builtin_amdgcn_s_getreg((3 << 11) | 20) & 0xFu; }
#define XB_SPIN(cond, bar) do { unsigned _sp = 0; while (cond) { __builtin_amdgcn_s_sleep(1); \
    if ((++_sp & 255u) == 0u) { if (xb_ld(&(bar)[XB_TMO])) break; if (_sp > XB_SPIN_CAP) { atomicAdd(&(bar)[XB_TMO], 1u); break; } } } } while (0)
struct XcdBarrier { unsigned* bar; unsigned x; volatile LAS unsigned* st; };
DEVI XcdBarrier xcd_barrier_post(unsigned* bar, volatile LAS unsigned* st) {
  XcdBarrier b; b.bar = bar; b.x = xb_xcc_id(); b.st = st;
  if (threadIdx.x == 0) (void)xb_add(&bar[XB_XCNT(b.x)], 1u);
  return b;
}
DEVI void xcd_barrier_complete(unsigned* bar, unsigned x, unsigned& nloc, unsigned& nx) {
  const unsigned G = gridDim.x * gridDim.y * gridDim.z;
  unsigned sum, cnt, mine, sp = 0u;
  for (;;) {
    sum = 0u; cnt = 0u; mine = 0u;
#pragma unroll
    for (unsigned j = 0; j < 16; ++j) { const unsigned c = xb_ld(&bar[XB_XCNT(j)]); sum += c; cnt += (c > 0u) ? 1u : 0u; mine = (j == x) ? c : mine; }
    if (sum == G) break;
    __builtin_amdgcn_s_sleep(1);
    if ((++sp & 255u) == 0u) { if (xb_ld(&bar[XB_TMO])) break; if (sp > XB_SPIN_CAP) { atomicAdd(&bar[XB_TMO], 1u); break; } }
  }
  nloc = mine > 0u ? mine : 1u; nx = cnt > 0u ? cnt : 1u;
}
DEVI void xcd_barrier(const XcdBarrier& b) {
  asm volatile("s_waitcnt vmcnt(0)" ::: "memory");
  __syncthreads();
  if (threadIdx.x == 0) {
    unsigned* bar = b.bar;
    __builtin_amdgcn_s_waitcnt(0);
    unsigned nloc = b.st[0], nx = b.st[1];
    if (nloc == 0u) { xcd_barrier_complete(bar, b.x, nloc, nx); b.st[0] = nloc; b.st[1] = nx; }
    const unsigned old = xb_add(&bar[XB_XSUB(b.x)], 1u);
    const unsigned gen = old / nloc;
    if (old + 1u == (gen + 1u) * nloc) {
      __builtin_amdgcn_fence(__ATOMIC_RELEASE, "agent");
      asm volatile("s_waitcnt vmcnt(0)" ::: "memory");
      const unsigned og = xb_add(&bar[XB_TOP], 1u);
      const unsigned tg = og / nx;
      if (og + 1u == (tg + 1u) * nx) xb_add(&bar[XB_TOPGEN], 1u);
      else XB_SPIN(xb_ld(&bar[XB_TOPGEN]) == tg, bar);
      __builtin_amdgcn_fence(__ATOMIC_ACQUIRE, "agent");
      xb_add(&bar[XB_XGEN(b.x)], 1u);
      asm volatile("s_waitcnt vmcnt(0)" ::: "memory");
    } else {
      XB_SPIN(xb_ld(&bar[XB_XGEN(b.x)]) == gen, bar);
      __builtin_amdgcn_fence(__ATOMIC_ACQUIRE, "agent");
      asm volatile("s_waitcnt vmcnt(0)" ::: "memory");
    }
  }
  __syncthreads();
}

DEVI void transpose_tile(const float* __restrict__ src, int N, int K, int k0, int n0, u16* __restrict__ dst,
                         float* tile) {
  const int tid = TIDX;
  for (int e = tid; e < 4096; e += 256) {
    int r = e >> 6, cc = e & 63;
    tile[r * 65 + cc] = src[(size_t)(k0 + r) * N + n0 + cc];
  }
  __syncthreads();
  for (int e = tid; e < 4096; e += 256) {
    int n = e >> 6, k = e & 63;
    dst[(size_t)(n0 + n) * K + k0 + k] = f2bf(tile[k * 65 + n]);
  }
  __syncthreads();
}
DEVI void convert_weight(const float* src, int K, int N, u16* dst, float* tile, int t0, int stride) {
  const int nk = K >> 6, nn = N >> 6;
  for (int t = t0; t < nk * nn; t += stride) transpose_tile(src, N, K, (t % nk) * 64, (t / nk) * 64, dst, tile);
}

DEVI void mod_task(const Params& p, int task, float* sm) {
  const int l = task / 48, n0 = (task % 48) * 64;
  const int tid = TIDX;
  for (int e = tid; e < 3072; e += 256) {
    int bi = e >> 10, k = e & 1023;
    float v = bi < 2 ? p.c[bi * 1024 + k] : p.c_ctx[k];
    sm[e] = silu_f(v);
  }
  __syncthreads();
  const int c4 = tid & 15, kg = tid >> 4;
  const float* w = p.w_ada + (size_t)l * 1024 * 3072 + n0 + c4 * 4;
  float4 a0 = float4{0.f, 0.f, 0.f, 0.f}, a1 = a0, a2 = a0;
#pragma unroll 16
  for (int k = kg * 64; k < kg * 64 + 64; ++k) {
    const float4 wv = *(const float4*)(w + (size_t)k * 3072);
    const float s0 = sm[k], s1 = sm[1024 + k], s2 = sm[2048 + k];
    a0.x += s0 * wv.x; a0.y += s0 * wv.y; a0.z += s0 * wv.z; a0.w += s0 * wv.w;
    a1.x += s1 * wv.x; a1.y += s1 * wv.y; a1.z += s1 * wv.z; a1.w += s1 * wv.w;
    a2.x += s2 * wv.x; a2.y += s2 * wv.y; a2.z += s2 * wv.z; a2.w += s2 * wv.w;
  }
  float* red = sm + 3072;
  *(float4*)(red + (kg * 3 + 0) * 64 + c4 * 4) = a0;
  *(float4*)(red + (kg * 3 + 1) * 64 + c4 * 4) = a1;
  *(float4*)(red + (kg * 3 + 2) * 64 + c4 * 4) = a2;
  __syncthreads();
  if (tid < 192) {
    int bi = tid >> 6, cc = tid & 63;
    float s = p.b_ada[l * 3072 + n0 + cc];
    for (int q = 0; q < 16; ++q) s += red[(q * 3 + bi) * 64 + cc];
    float* mod = (float*)(p.ws + OFF_MOD);
    mod[(l * 3 + bi) * 3072 + n0 + cc] = s;
  }
  __syncthreads();
}

DEVI void prologue_phase(const Params& p, unsigned char* smem) {
  float* tile = (float*)smem;
  const int bid = BIDX;
  convert_weight(p.w_in, 1024, 3840, (u16*)(p.ws + OFF_WINT), tile, bid, gridDim.x);
  for (int t = bid; t < 96; t += gridDim.x) {
    int ct = t % 6, mat = t / 6;
    int kind = mat & 1, ld = mat >> 1;
    const float* src = (kind ? p.rw_a_up : p.rw_w_up) + (size_t)ld * 64 * 384;
    transpose_tile(src, 384, 64, 0, ct * 64, (u16*)(p.ws + OFF_LORA) + (size_t)mat * 384 * 64, tile);
  }
  for (int t = bid; t < 192; t += gridDim.x) mod_task(p, t, tile);
  if (bid == (int)gridDim.x - 1) {
    float* rope = (float*)(p.ws + OFF_ROPE);
    for (int e = TIDX; e < 2048; e += 256) {
      int pos = e >> 4, f = e & 15;
      float inv = exp2f(-(float)f * (13.287712379549449f / 16.f));
      float ang = (float)pos * inv;
      rope[e * 2] = cosf(ang);
      rope[e * 2 + 1] = sinf(ang);
    }
  }
}

DEVI void norm_phase(const Params& p, int l) {
  const int tid = TIDX;
  const int lane = tid & 63;
  const int gw = BIDX * 4 + (tid >> 6), nw = gridDim.x * 4;
  const float* xs = l == 0 ? p.x : p.out;
  const float* xcs = l == 0 ? p.ctx : (const float*)(p.ws + OFF_XC);
  const float* mod = (const float*)(p.ws + OFF_MOD) + (size_t)l * 3 * 3072;
  const float* ng = p.norm_g + l * 1024;
  u16* H = (u16*)(p.ws + OFF_H);
  for (int m = gw; m < MT; m += nw) {
    const float* row = m < ML ? xs + (size_t)m * 1024 : xcs + (size_t)(m - ML) * 1024;
    const int bi = m < 8192 ? 0 : (m < ML ? 1 : 2);
    float4 v[4];
    float ss = 0.f;
#pragma unroll
    for (int i = 0; i < 4; ++i) {
      v[i] = *(const float4*)(row + i * 256 + lane * 4);
      ss += v[i].x * v[i].x + v[i].y * v[i].y + v[i].z * v[i].z + v[i].w * v[i].w;
    }
    ss = wave_sum(ss);
    const float inv = rsqrtf(ss * (1.f / 1024.f) + 1e-6f);
    const float* md = mod + bi * 3072;
#pragma unroll
    for (int i = 0; i < 4; ++i) {
      const int c0 = i * 256 + lane * 4;
      float4 g4 = *(const float4*)(ng + c0);
      float4 sh = *(const float4*)(md + c0);
      float4 sc = *(const float4*)(md + 1024 + c0);
      float o0 = v[i].x * inv * g4.x * (1.f + sc.x) + sh.x;
      float o1 = v[i].y * inv * g4.y * (1.f + sc.y) + sh.y;
      float o2 = v[i].z * inv * g4.z * (1.f + sc.z) + sh.z;
      float o3 = v[i].w * inv * g4.w * (1.f + sc.w) + sh.w;
      uint2 pk;
      pk.x = pack2bf(o0, o1);
      pk.y = pack2bf(o2, o3);
      *(uint2*)(H + (size_t)m * 1024 + c0) = pk;
    }
  }
}

template <int MODE>
DEVI void gemm_phase(const Params& p, int l, unsigned char* smem, int tb0, int tbs) {
  constexpr int KT0 = MODE == 2 ? 6 : 0;
  constexpr int NKT = MODE == 0 ? 16 : (MODE == 1 ? 6 : 10);
  u16* sA = (u16*)smem;
  u16* sB = sA + 128 * 64;
  const int tid = TIDX, lane = tid & 63, wave = tid >> 6, wm = wave >> 1, wn = wave & 1;
  const int fr = lane & 15, g = lane >> 4;
  const int ntn = MODE == 0 ? 30 : 8;
  const int ntm = MODE == 0 ? 132 : (l < 3 ? 132 : 128);
  const bool TRfix = MODE != 0;
  const u16* A = MODE == 0 ? (const u16*)(p.ws + OFF_H) : (const u16*)(p.ws + OFF_P);
  const int lda = MODE == 0 ? 1024 : PW;
  const u16* Bt = MODE == 0 ? (const u16*)(p.ws + OFF_WINT) : (const u16*)(p.ws + OFF_WOUTT);
  u16* P = (u16*)(p.ws + OFF_P);

  const int ntiles = ntm * ntn;
#define TILE_OF(t0v) ((MODE != 2 && tbs == 512) ? (((t0v) & ~511) + (((t0v) & 7) << 6) + (((t0v) & 511) >> 3)) : (t0v))
  const int lrow = tid >> 3, lseg = tid & 7;
  const int soff = lrow * 64 + ((lseg ^ ((lrow >> 1) & 7)) << 3);
  uint4 xa0, xa1, xa2, xa3, xb0, xb1, xb2, xb3;
  uint4 ya0, ya1, ya2, ya3, yb0, yb1, yb2, yb3;
  const u16* aptr;
  const u16* bptr;
#define ACOL(kt) (MODE == 0 ? (kt) * 64 : ((kt) < 6 ? C_G + (kt) * 64 : ((kt) < 12 ? C_GA + ((kt) - 6) * 64 : C_BG + ((kt) - 12) * 64)))
#define GLOAD(P, kt)                                                           \
  {                                                                            \
    const int acol_ = ACOL(kt);                                                \
    P##a0 = *(const uint4*)(aptr + acol_);                                     \
    P##a1 = *(const uint4*)(aptr + (size_t)32 * lda + acol_);                  \
    P##a2 = *(const uint4*)(aptr + (size_t)64 * lda + acol_);                  \
    P##a3 = *(const uint4*)(aptr + (size_t)96 * lda + acol_);                  \
    P##b0 = *(const uint4*)(bptr + (kt) * 64);                                 \
    P##b1 = *(const uint4*)(bptr + 32 * 1024 + (kt) * 64);                     \
    P##b2 = *(const uint4*)(bptr + 64 * 1024 + (kt) * 64);                     \
    P##b3 = *(const uint4*)(bptr + 96 * 1024 + (kt) * 64);                     \
  }
#define SSTORE(P, buf)                                                         \
  {                                                                            \
    u16* sa_ = sA + (buf) * 16384 + soff;                                      \
    u16* sb_ = sa_ + 128 * 64;                                                 \
    *(uint4*)(sa_) = P##a0;                                                    \
    *(uint4*)(sa_ + 32 * 64) = P##a1;                                          \
    *(uint4*)(sa_ + 64 * 64) = P##a2;                                          \
    *(uint4*)(sa_ + 96 * 64) = P##a3;                                          \
    *(uint4*)(sb_) = P##b0;                                                    \
    *(uint4*)(sb_ + 32 * 64) = P##b1;                                          \
    *(uint4*)(sb_ + 64 * 64) = P##b2;                                          \
    *(uint4*)(sb_ + 96 * 64) = P##b3;                                          \
  }
#define COMPUTE(buf)                                                           \
  {                                                                            \
    const u16* c1_ = s1 + (buf) * 16384;                                       \
    const u16* c2_ = s2 + (buf) * 16384;                                       \
    _Pragma("unroll") for (int s = 0; s < 2; ++s) {                            \
      bf16x8 f1[4], f2[4];                                                     \
      const int sw_ = ((4 * s + g) ^ (fr >> 1)) << 3;                          \
      _Pragma("unroll") for (int i = 0; i < 4; ++i) {                          \
        f1[i] = *(const bf16x8*)(c1_ + (w1 + i * 16 + fr) * 64 + sw_);         \
        f2[i] = *(const bf16x8*)(c2_ + (w2 + i * 16 + fr) * 64 + sw_);         \
      }                                                                        \
      _Pragma("unroll") for (int i = 0; i < 4; ++i)                            \
        _Pragma("unroll") for (int j = 0; j < 4; ++j) acc[i][j] = mfma16(f1[i], f2[j], acc[i][j]); \
    }                                                                          \
  }
#define TM_OF(t) (MODE == 0 ? ((t) < 3168 ? ((t) % 1056) / 8 : ((t) - 3168) / 6) : (t) / ntn)
#define TN_OF(t) (MODE == 0 ? ((t) < 3168 ? ((t) / 1056) * 8 + ((t) & 7) : 24 + ((t) - 3168) % 6) : (t) % ntn)
  int t0 = tb0;
  int t = TILE_OF(t0);
  bool have = t < ntiles;
  if (have) {
    aptr = A + (size_t)(TM_OF(t) * 128 + lrow) * lda + lseg * 8;
    bptr = Bt + (size_t)(TN_OF(t) * 128 + lrow) * 1024 + lseg * 8;
    GLOAD(x, KT0);
    GLOAD(y, KT0 + 1);
  }
  while (have) {
    const int tn = TN_OF(t), tm = TM_OF(t);
    const int m0 = tm * 128, n0 = tn * 128;
    bool TR = TRfix;
    if (MODE == 0) TR = !((tn >= 6 && tn < 9) || tn == 18);
    const u16* s1 = TR ? sB : sA;
    const u16* s2 = TR ? sA : sB;
    const int w1 = (TR ? wn : wm) * 64, w2 = (TR ? wm : wn) * 64;

    f32x4 acc[4][4];
#pragma unroll
    for (int i = 0; i < 4; ++i)
#pragma unroll
      for (int j = 0; j < 4; ++j) acc[i][j] = f32x4{0.f, 0.f, 0.f, 0.f};

    __syncthreads();
    SSTORE(x, 0);
    GLOAD(x, KT0 + 2);
    __syncthreads();
#pragma unroll 1
    for (int kt = 0; kt < NKT; kt += 2) {
      SSTORE(y, 1);
      if (kt + 3 < NKT) GLOAD(y, KT0 + kt + 3);
      COMPUTE(0);
      __syncthreads();
      if (kt + 2 < NKT) SSTORE(x, 0);
      if (kt + 4 < NKT) GLOAD(x, KT0 + kt + 4);
      COMPUTE(1);
      __syncthreads();
    }
    t0 += tbs;
    const int tnext = TILE_OF(t0);
    const bool havenext = tnext < ntiles;
    if (havenext) {
      aptr = A + (size_t)(TM_OF(tnext) * 128 + lrow) * lda + lseg * 8;
      bptr = Bt + (size_t)(TN_OF(tnext) * 128 + lrow) * 1024 + lseg * 8;
      GLOAD(x, KT0);
      GLOAD(y, KT0 + 1);
    }

    if (MODE != 0) {
      const float* mod = (const float*)(p.ws + OFF_MOD) + (size_t)l * 3 * 3072;
#pragma unroll
      for (int b2 = 0; b2 < 4; ++b2) {
        const int m = m0 + wm * 64 + b2 * 16 + fr;
        const int bi = m < 8192 ? 0 : (m < ML ? 1 : 2);
        const float* src;
        float* dst;
        if (m < ML) {
          src = ((MODE == 2 && l == 0) ? p.x : p.out) + (size_t)m * 1024;
          dst = p.out + (size_t)m * 1024;
        } else {
          src = ((MODE == 2 && l == 0) ? p.ctx : (const float*)(p.ws + OFF_XC)) + (size_t)(m - ML) * 1024;
          dst = (float*)(p.ws + OFF_XC) + (size_t)(m - ML) * 1024;
        }
#pragma unroll
        for (int a = 0; a < 4; ++a) {
          const int n = n0 + wn * 64 + a * 16 + 4 * g;
          float4 xo = *(const float4*)(src + n);
          float4 gt = *(const float4*)(mod + bi * 3072 + 2048 + n);
          float4 o;
          o.x = xo.x + gt.x * acc[a][b2][0];
          o.y = xo.y + gt.y * acc[a][b2][1];
          o.z = xo.z + gt.z * acc[a][b2][2];
          o.w = xo.w + gt.w * acc[a][b2][3];
          *(float4*)(dst + n) = o;
        }
      }
    } else {
      const int nbase = n0 + wn * 64;
      if (!TR) {
        if (tn == 18) {
#pragma unroll
          for (int mt = 0; mt < 4; ++mt) {
            const int mb = m0 + wm * 64 + mt * 16 + 4 * g;
#pragma unroll
            for (int nt = 0; nt < 4; ++nt) {
              const int hc = nbase - 2304 + nt * 16 + fr;
              const int kvh = hc >> 6, d = hc & 63;
              uint2 pk;
              pk.x = pack2bf(acc[mt][nt][0], acc[mt][nt][1]);
              pk.y = pack2bf(acc[mt][nt][2], acc[mt][nt][3]);
              if (mb < ML) {
                const int b = mb >> 13, tk = mb & 8191;
                u16* dst = (u16*)(p.ws + OFF_VT) + ((size_t)((b * 2 + kvh) * 64 + d)) * 8192 + tk;
                *(uint2*)dst = pk;
              } else {
                const int mm = mb - ML, b = mm >> 8, tk = mm & 255;
                u16* dst = (u16*)(p.ws + OFF_VTC) + ((size_t)((b * 2 + kvh) * 64 + d)) * 256 + tk;
                *(uint2*)dst = pk;
              }
            }
          }
        } else {
#pragma unroll
          for (int mt = 0; mt < 4; ++mt) {
            const int tg = ((m0 + wm * 64 + mt * 16) >> 2) + g;
#pragma unroll
            for (int nt = 0; nt < 4; ++nt) {
              const int hc = nbase - 768 + nt * 16 + fr;
              const int h = hc >> 6, rv = hc & 63;
              h4 hv;
              hv[0] = (_Float16)acc[mt][nt][0];
              hv[1] = (_Float16)acc[mt][nt][1];
              hv[2] = (_Float16)acc[mt][nt][2];
              hv[3] = (_Float16)acc[mt][nt][3];
              *(h4*)(p.ws + OFF_V4 + ((size_t)(tg * 6 + h) * 64 + rv) * 8) = hv;
            }
          }
        }
      } else {
        const int pc = nbase < 768 ? nbase : (nbase < 2304 ? nbase - 384 : nbase - 512);
        const bool rope = (tn >= 14 && tn < 18);
        const float* ropeT = (const float*)(p.ws + OFF_ROPE);
#pragma unroll
        for (int b2 = 0; b2 < 4; ++b2) {
          const int m = m0 + wm * 64 + b2 * 16 + fr;
          if (rope && m < ML) {
            const int tk = m & 8191;
#pragma unroll
            for (int a = 0; a < 2; ++a) {
              const int pos = a == 0 ? (tk >> 6) : (tk & 63);
#pragma unroll
              for (int i = 0; i < 4; ++i) {
                const int f = 4 * g + i;
                const float cs = ropeT[(pos * 16 + f) * 2], sn = ropeT[(pos * 16 + f) * 2 + 1];
                const float t1 = acc[a][b2][i], t2 = acc[a + 2][b2][i];
                acc[a][b2][i] = t1 * cs - t2 * sn;
                acc[a + 2][b2][i] = t1 * sn + t2 * cs;
              }
            }
          }
          if (tn == 12) {
#pragma unroll
            for (int a = 0; a < 4; ++a)
#pragma unroll
              for (int i = 0; i < 4; ++i) acc[a][b2][i] = tanh_f(acc[a][b2][i]);
          }
#pragma unroll
          for (int a = 0; a < 4; ++a) {
            uint2 pk;
            pk.x = pack2bf(acc[a][b2][0], acc[a][b2][1]);
            pk.y = pack2bf(acc[a][b2][2], acc[a][b2][3]);
            *(uint2*)(sA + (wm * 64 + b2 * 16 + fr) * 136 + wn * 64 + a * 16 + 4 * g) = pk;
          }
        }
        __syncthreads();
        {
          const int pc0 = n0 < 768 ? n0 : (n0 < 2304 ? n0 - 384 : n0 - 512);
#pragma unroll
          for (int q = 0; q < 8; ++q) {
            const int c = tid + 256 * q, row = c >> 4, ch = c & 15;
            const uint4 v = *(const uint4*)(sA + row * 136 + ch * 8);
            *(uint4*)(P + (size_t)(m0 + row) * PW + pc0 + ch * 8) = v;
          }
        }
      }
    }
    t = tnext;
    have = havenext;
  }
#undef GLOAD
#undef SSTORE
#undef COMPUTE
#undef ACOL
#undef TILE_OF
#undef TM_OF
#undef TN_OF
}

DEVI void prep_wave_task(const Params& p, int l, int m0, int h, int lane) {
  const int fr = lane & 15, g = lane >> 4;
  const u16* __restrict__ P = (const u16*)(p.ws + OFF_P);
  const u16* __restrict__ Prow = P + (size_t)(m0 + fr) * PW;
  const u16* __restrict__ LT = (const u16*)(p.ws + OFF_LORA);
  u16 kraw[4][4], rraw[4][4];
  float kkp[4], kap[4], rkp[4];
#pragma unroll
  for (int i = 0; i < 4; ++i) {
    const u16* q = P + (size_t)(m0 + 4 * g + i) * PW + h * 64 + fr;
#pragma unroll
    for (int nt = 0; nt < 4; ++nt) {
      kraw[i][nt] = q[C_K + nt * 16];
      rraw[i][nt] = q[C_R + nt * 16];
    }
  }
#pragma unroll
  for (int nt = 0; nt < 4; ++nt) {
    const int c = h * 64 + nt * 16 + fr;
    kkp[nt] = p.rw_k_k[l * 384 + c];
    kap[nt] = p.rw_k_a[l * 384 + c];
    rkp[nt] = p.rw_r_k[l * 384 + c];
  }
  __builtin_amdgcn_sched_barrier(0);
  float kf[4][4], rf[4][4], rn[4], bs[4];
#pragma unroll
  for (int i = 0; i < 4; ++i) {
    float ss = 0.f, b2 = 0.f;
#pragma unroll
    for (int nt = 0; nt < 4; ++nt) {
      kf[i][nt] = bf2f(kraw[i][nt]);
      rf[i][nt] = bf2f(rraw[i][nt]);
      const float kr = kf[i][nt] * kkp[nt];
      ss += kr * kr;
      b2 += rf[i][nt] * kf[i][nt] * rkp[nt];
    }
    ss = reduce16(ss);
    bs[i] = reduce16(b2);
    rn[i] = rsqrtf(fmaxf(ss, 1e-12f));
  }
  const int tg = (m0 >> 2) + g;
#pragma unroll 1
  for (int d = 0; d < 2; ++d) {
    f32x4 accw[4], acca[4];
    float w0v[4], a0v[4];
    bf16x8 aw[2], aa[2];
#pragma unroll
    for (int nt = 0; nt < 4; ++nt) {
      accw[nt] = f32x4{0.f, 0.f, 0.f, 0.f};
      acca[nt] = f32x4{0.f, 0.f, 0.f, 0.f};
      w0v[nt] = p.rw_w0[(l * 2 + d) * 384 + h * 64 + nt * 16 + fr];
      a0v[nt] = p.rw_a0[(l * 2 + d) * 384 + h * 64 + nt * 16 + fr];
    }
#pragma unroll
    for (int s = 0; s < 2; ++s) {
      aw[s] = *(const bf16x8*)(Prow + C_WD + d * 64 + s * 32 + g * 8);
      aa[s] = *(const bf16x8*)(Prow + C_AD + d * 64 + s * 32 + g * 8);
    }
#pragma unroll
    for (int s = 0; s < 2; ++s) {
      bf16x8 bw[4], ba[4];
#pragma unroll
      for (int nt = 0; nt < 4; ++nt) {
        const size_t rw = (size_t)(h * 64 + nt * 16 + fr) * 64 + s * 32 + g * 8;
        bw[nt] = *(const bf16x8*)(LT + (size_t)((l * 2 + d) * 2 + 0) * 384 * 64 + rw);
        ba[nt] = *(const bf16x8*)(LT + (size_t)((l * 2 + d) * 2 + 1) * 384 * 64 + rw);
      }
      __builtin_amdgcn_sched_barrier(0);
#pragma unroll
      for (int nt = 0; nt < 4; ++nt) {
        accw[nt] = mfma16(aw[s], bw[nt], accw[nt]);
        acca[nt] = mfma16(aa[s], ba[nt], acca[nt]);
      }
    }
#pragma unroll
    for (int nt = 0; nt < 4; ++nt) {
      const int cl = nt * 16 + fr;
      const float w0 = w0v[nt];
      const float a0 = a0v[nt];
      h4 hu, hn, hk;
#pragma unroll
      for (int i = 0; i < 4; ++i) {
        const float sig = sigmoid_f(w0 + accw[nt][i]);
        const float u = 1.f - __expf(-0.60653066f * sig);
        const float av = sigmoid_f(a0 + acca[nt][i]);
        hu[i] = (_Float16)u;
        hn[i] = (_Float16)(-(kf[i][nt] * kkp[nt] * rn[i]) * av);
        hk[i] = (_Float16)(kf[i][nt] * (1.f + (av - 1.f) * kap[nt]));
      }
      unsigned char* base = p.ws + OFF_DD + (size_t)d * SZ_DD1 + ((size_t)(tg * 6 + h) * 64 + cl) * 24;
      *(h4*)base = hu;
      *(h4*)(base + 8) = hn;
      *(h4*)(base + 16) = hk;
    }
  }
#pragma unroll
  for (int nt = 0; nt < 4; ++nt) {
    const int c = nt * 16 + fr;
    unsigned char* base = p.ws + OFF_DI + ((size_t)(tg * 6 + h) * 64 + c) * 16;
    h8 ab;
#pragma unroll
    for (int i = 0; i < 4; ++i) {
      ab[i] = (_Float16)(kf[i][nt] * kkp[nt] * rn[i]);
      ab[4 + i] = (_Float16)rf[i][nt];
    }
    *(h8*)base = ab;
  }
  if (fr == 0) {
#pragma unroll
    for (int i = 0; i < 4; ++i) ((float*)(p.ws + OFF_BONUS))[(size_t)(m0 + 4 * g + i) * 6 + h] = bs[i];
  }
}

DEVI void prep_phase(const Params& p, int l, unsigned char* smem) {
  const int tid = TIDX, lane = tid & 63;
  const int bid = BIDX;
  u16* P = (u16*)(p.ws + OFF_P);
  const int gw = bid * 4 + (tid >> 6), nw = (int)gridDim.x * 4;
  for (int wt = gw; wt < (MT / 16) * 6; wt += nw) prep_wave_task(p, l, (wt / 6) * 16, wt % 6, lane);
#pragma unroll 1
  for (int item = bid * 256 + tid; item < MT * 32; item += (int)gridDim.x * 256) {
      const int m = item >> 5, ch = (item & 31) * 8;
      int pos, last;
      if (m < ML) { pos = m & 8191; last = 8191; } else { pos = (m - ML) & 255; last = 255; }
      const u16* row = P + (size_t)m * PW;
      float uc[8], up[8], un[8];
      {
        bf16x8 a = *(const bf16x8*)(row + C_CG + ch), b = *(const bf16x8*)(row + C_XIN + ch);
#pragma unroll
        for (int e = 0; e < 8; ++e) uc[e] = bf2f((u16)a[e]) * bf2f((u16)b[e]);
      }
      if (pos > 0) {
        bf16x8 a = *(const bf16x8*)(row - PW + C_CG + ch), b = *(const bf16x8*)(row - PW + C_XIN + ch);
#pragma unroll
        for (int e = 0; e < 8; ++e) up[e] = bf2f((u16)a[e]) * bf2f((u16)b[e]);
      } else {
#pragma unroll
        for (int e = 0; e < 8; ++e) up[e] = 0.f;
      }
      if (pos < last) {
        bf16x8 a = *(const bf16x8*)(row + PW + C_CG + ch), b = *(const bf16x8*)(row + PW + C_XIN + ch);
#pragma unroll
        for (int e = 0; e < 8; ++e) un[e] = bf2f((u16)a[e]) * bf2f((u16)b[e]);
      } else {
#pragma unroll
        for (int e = 0; e < 8; ++e) un[e] = 0.f;
      }
      bf16x8 bg = *(const bf16x8*)(row + C_BG + ch), gc = *(const bf16x8*)(row + C_GCV + ch);
      const float* cw = p.cv_w + l * 768;
      unsigned o[4];
#pragma unroll
      for (int e = 0; e < 8; e += 2) {
        float y0 = up[e] * cw[ch + e] + uc[e] * cw[256 + ch + e] + un[e] * cw[512 + ch + e];
        float y1 = up[e + 1] * cw[ch + e + 1] + uc[e + 1] * cw[256 + ch + e + 1] + un[e + 1] * cw[512 + ch + e + 1];
        y0 = bf2f((u16)bg[e]) * y0 * silu_f(bf2f((u16)gc[e]));
        y1 = bf2f((u16)bg[e + 1]) * y1 * silu_f(bf2f((u16)gc[e + 1]));
        o[e >> 1] = pack2bf(y0, y1);
      }
      *(uint4*)(P + (size_t)m * PW + C_BG + ch) = uint4{o[0], o[1], o[2], o[3]};
  }
}

constexpr int CHUNK_B = 20992;
#define SCAN_RED_HEAD(OS)                                                                                     \
  "v_fma_mix_f32 %[pp], %[kk0], %[S0], 0 op_sel:[" OS ",0,0] op_sel_hi:[1,0,0]\n\t"                           \
  "v_fma_mix_f32 %[pp], %[kk1], %[S1], %[pp] op_sel:[" OS ",0,0] op_sel_hi:[1,0,0]\n\t"                       \
  "v_fma_mix_f32 %[T0], -%[u0], %[S0], %[S0] op_sel:[" OS ",0,0] op_sel_hi:[1,0,0]\n\t"                       \
  "v_fma_mix_f32 %[T1], -%[u1], %[S1], %[S1] op_sel:[" OS ",0,0] op_sel_hi:[1,0,0]\n\t"                       \
  "v_add_f32_dpp %[pp], %[pp], %[pp] quad_perm:[1,0,3,2] row_mask:0xf bank_mask:0xf bound_ctrl:1\n\t"         \
  "v_fma_mix_f32 %[T0], %[vd], %[kd0], %[T0] op_sel:[" OS "," OS ",0] op_sel_hi:[1,1,0]\n\t"                  \
  "v_fma_mix_f32 %[T1], %[vd], %[kd1], %[T1] op_sel:[" OS "," OS ",0] op_sel_hi:[1,1,0]\n\t"                  \
  "v_add_f32_dpp %[pp], %[pp], %[pp] quad_perm:[2,3,0,1] row_mask:0xf bank_mask:0xf bound_ctrl:1\n\t"
#define SCAN_RED_TAIL(OS)                                                                                     \
  "v_add_f32_dpp %[pp], %[pp], %[pp] row_half_mirror row_mask:0xf bank_mask:0xf bound_ctrl:1\n\t"             \
  "s_nop 1\n\t"                                                                                               \
  "v_add_f32_dpp %[pp], %[pp], %[pp] row_mirror row_mask:0xf bank_mask:0xf bound_ctrl:1\n\t"                  \
  "v_mov_b32 %[tmp], %[pp]\n\t"                                                                               \
  "s_nop 1\n\t"                                                                                               \
  "v_permlane16_swap_b32 %[pp], %[tmp]\n\t"                                                                   \
  "v_add_f32 %[pp], %[pp], %[tmp]\n\t"                                                                        \
  "v_fma_mix_f32 %[S0], %[nk0], %[pp], %[T0] op_sel:[" OS ",0,0] op_sel_hi:[1,0,0]\n\t"                       \
  "v_fma_mix_f32 %[S1], %[nk1], %[pp], %[T1] op_sel:[" OS ",0,0] op_sel_hi:[1,0,0]\n\t"
#define SCAN_PY(OS, Y)                                                                                        \
  "v_fma_mix_f32 %[" Y "], %[r0], %[S0], 0 op_sel:[" OS ",0,0] op_sel_hi:[1,0,0]\n\t"                         \
  "v_fma_mix_f32 %[" Y "], %[r1], %[S1], %[" Y "] op_sel:[" OS ",0,0] op_sel_hi:[1,0,0]\n\t"
#define SCAN_PY_LAST(OS, Y)                                                                                   \
  "v_fma_mix_f32 %[" Y "], %[r0], %[S0], 0 op_sel:[" OS ",0,0] op_sel_hi:[1,0,0]\n\t"                         \
  "v_fma_mix_f32 %[" Y "], %[r1], %[S1], %[" Y "] op_sel:[" OS ",0,0] op_sel_hi:[1,0,0]"
#define SCAN_PAIR_ASM(OSA, OSB)                                                                               \
  SCAN_RED_HEAD(OSA) "s_nop 1\n\t" SCAN_RED_TAIL(OSA)                                                         \
  SCAN_RED_HEAD(OSB) SCAN_PY(OSA, "ya") SCAN_RED_TAIL(OSB)                                                    \
  SCAN_PY_LAST(OSB, "yb")
#define DPPQ "row_mask:0xf bank_mask:0xf bound_ctrl:1\n\t"
#define SCAN_TAIL_W(OS, N1, N2)                                                                               \
  "v_add_f32_dpp %[pp], %[pp], %[pp] row_half_mirror " DPPQ N1                                               \
  "v_add_f32_dpp %[pp], %[pp], %[pp] row_mirror " DPPQ                                                       \
  "v_mov_b32 %[tmp], %[pp]\n\t" N2                                                                            \
  "v_permlane16_swap_b32 %[pp], %[tmp]\n\t"                                                                   \
  "v_add_f32 %[pp], %[pp], %[tmp]\n\t"                                                                        \
  "v_fma_mix_f32 %[S0], %[nk0], %[pp], %[T0] op_sel:[" OS ",0,0] op_sel_hi:[1,0,0]\n\t"                       \
  "v_fma_mix_f32 %[S1], %[nk1], %[pp], %[T1] op_sel:[" OS ",0,0] op_sel_hi:[1,0,0]\n\t"
#define R1_2  "v_cndmask_b32_e64 %[t1], %[a1], %[a0], %[m0]\n\t" "v_cndmask_b32_e64 %[t3], %[a3], %[a2], %[m0]\n\t"
#define R3_4  "v_cndmask_b32_e64 %[t0], %[a0], %[a1], %[m0]\n\t" "v_cndmask_b32_e64 %[t2], %[a2], %[a3], %[m0]\n\t"
#define R5_6  "v_add_f32_dpp %[t0], %[t1], %[t0] quad_perm:[1,0,3,2] " DPPQ "v_add_f32_dpp %[t2], %[t3], %[t2] quad_perm:[1,0,3,2] " DPPQ
#define R7_8  "v_cndmask_b32_e64 %[t3], %[t2], %[t0], %[m1]\n\t" "v_cndmask_b32_e64 %[t1], %[t0], %[t2], %[m1]\n\t"
#define R9    "v_add_f32_dpp %[t1], %[t3], %[t1] quad_perm:[2,3,0,1] " DPPQ "s_nop 0\n\t"
#define R10   "v_add_f32_dpp %[t1], %[t1], %[t1] row_ror:4 " DPPQ "s_nop 0\n\t"
#define R11   "v_add_f32_dpp %[t1], %[t1], %[t1] row_ror:8 " DPPQ "s_nop 0\n\t"
#define R12   "v_mov_b32 %[t3], %[t1]\n\t" "s_nop 0\n\t"
#define R13_14 "v_permlane16_swap_b32 %[t1], %[t3]\n\t" "v_add_f32 %[t1], %[t1], %[t3]\n\t"
#define SCAN_PAIR1_ASM(OSA, OSB)                                                                              \
  SCAN_RED_HEAD(OSA) R1_2 SCAN_TAIL_W(OSA, R3_4, R5_6)                                                        \
  SCAN_RED_HEAD(OSB) SCAN_PY(OSA, "ya") SCAN_TAIL_W(OSB, R7_8, R9)                                            \
  SCAN_PY_LAST(OSB, "yb")
#define SCAN_PAIR2_ASM(OSA, OSB)                                                                              \
  SCAN_RED_HEAD(OSA) R10 SCAN_TAIL_W(OSA, R11, R12)                                                           \
  SCAN_RED_HEAD(OSB) SCAN_PY(OSA, "ya") SCAN_TAIL_W(OSB, R13_14, "s_nop 1\n\t")                               \
  SCAN_PY_LAST(OSB, "yb")
template <int FIRST>
DEVI void scan_pair(float& S0, float& S1, float& ya, float& yb, unsigned kk0, unsigned r0, unsigned kk1, unsigned r1,
                    unsigned u0, unsigned nk0, unsigned kd0, unsigned u1, unsigned nk1, unsigned kd1, unsigned vd) {
  float pp, tmp, T0, T1;
  if (FIRST)
    asm(SCAN_PAIR_ASM("1", "0")
        : [S0] "+v"(S0), [S1] "+v"(S1), [ya] "=&v"(ya), [yb] "=&v"(yb), [pp] "=&v"(pp), [tmp] "=&v"(tmp),
          [T0] "=&v"(T0), [T1] "=&v"(T1)
        : [kk0] "v"(kk0), [kk1] "v"(kk1), [u0] "v"(u0), [u1] "v"(u1), [vd] "v"(vd), [kd0] "v"(kd0), [kd1] "v"(kd1),
          [nk0] "v"(nk0), [nk1] "v"(nk1), [r0] "v"(r0), [r1] "v"(r1));
  else
    asm(SCAN_PAIR_ASM("0", "1")
        : [S0] "+v"(S0), [S1] "+v"(S1), [ya] "=&v"(ya), [yb] "=&v"(yb), [pp] "=&v"(pp), [tmp] "=&v"(tmp),
          [T0] "=&v"(T0), [T1] "=&v"(T1)
        : [kk0] "v"(kk0), [kk1] "v"(kk1), [u0] "v"(u0), [u1] "v"(u1), [vd] "v"(vd), [kd0] "v"(kd0), [kd1] "v"(kd1),
          [nk0] "v"(nk0), [nk1] "v"(nk1), [r0] "v"(r0), [r1] "v"(r1));
}
#define PAIR_IO [S0] "+v"(S0), [S1] "+v"(S1), [ya] "=&v"(ya), [yb] "=&v"(yb), [pp] "=&v"(pp), [tmp] "=&v"(tmp), [T0] "=&v"(T0), [T1] "=&v"(T1)
#define PAIR_IN [kk0] "v"(kk0), [kk1] "v"(kk1), [u0] "v"(u0), [u1] "v"(u1), [vd] "v"(vd), [kd0] "v"(kd0), [kd1] "v"(kd1), [nk0] "v"(nk0), [nk1] "v"(nk1), [r0] "v"(r0), [r1] "v"(r1)
template <int FIRST>
DEVI void scan_pair1(float& S0, float& S1, float& ya, float& yb, float& t1, float a0, float a1, float a2, float a3,
                     unsigned long long m0, unsigned long long m1, unsigned kk0, unsigned r0, unsigned kk1, unsigned r1,
                     unsigned u0, unsigned nk0, unsigned kd0, unsigned u1, unsigned nk1, unsigned kd1, unsigned vd) {
  float pp, tmp, T0, T1, t0, t2, t3;
  if (FIRST)
    asm(SCAN_PAIR1_ASM("1", "0")
        : PAIR_IO, [t0] "=&v"(t0), [t1] "=&v"(t1), [t2] "=&v"(t2), [t3] "=&v"(t3)
        : PAIR_IN, [a0] "v"(a0), [a1] "v"(a1), [a2] "v"(a2), [a3] "v"(a3), [m0] "s"(m0), [m1] "s"(m1));
  else
    asm(SCAN_PAIR1_ASM("0", "1")
        : PAIR_IO, [t0] "=&v"(t0), [t1] "=&v"(t1), [t2] "=&v"(t2), [t3] "=&v"(t3)
        : PAIR_IN, [a0] "v"(a0), [a1] "v"(a1), [a2] "v"(a2), [a3] "v"(a3), [m0] "s"(m0), [m1] "s"(m1));
}
template <int FIRST>
DEVI void scan_pair2(float& S0, float& S1, float& ya, float& yb, float& t1, unsigned kk0, unsigned r0, unsigned kk1,
                     unsigned r1, unsigned u0, unsigned nk0, unsigned kd0, unsigned u1, unsigned nk1, unsigned kd1,
                     unsigned vd) {
  float pp, tmp, T0, T1, t3;
  if (FIRST)
    asm(SCAN_PAIR2_ASM("1", "0") : PAIR_IO, [t1] "+v"(t1), [t3] "=&v"(t3) : PAIR_IN);
  else
    asm(SCAN_PAIR2_ASM("0", "1") : PAIR_IO, [t1] "+v"(t1), [t3] "=&v"(t3) : PAIR_IN);
}

DEVI float treduce4_asm(float a0, float a1, float a2, float a3, unsigned long long m0, unsigned long long m1) {
  float t0, t1, t2, t3;
  asm("v_cndmask_b32_e64 %[t1], %[a1], %[a0], %[m0]\n\t"
      "v_cndmask_b32_e64 %[t3], %[a3], %[a2], %[m0]\n\t"
      "v_cndmask_b32_e64 %[t0], %[a0], %[a1], %[m0]\n\t"
      "v_cndmask_b32_e64 %[t2], %[a2], %[a3], %[m0]\n\t"
      "v_add_f32_dpp %[t0], %[t1], %[t0] quad_perm:[1,0,3,2] row_mask:0xf bank_mask:0xf bound_ctrl:1\n\t"
      "v_add_f32_dpp %[t2], %[t3], %[t2] quad_perm:[1,0,3,2] row_mask:0xf bank_mask:0xf bound_ctrl:1\n\t"
      "s_nop 0\n\t"
      "v_cndmask_b32_e64 %[t3], %[t2], %[t0], %[m1]\n\t"
      "v_cndmask_b32_e64 %[t1], %[t0], %[t2], %[m1]\n\t"
      "s_nop 0\n\t"
      "v_add_f32_dpp %[t1], %[t3], %[t1] quad_perm:[2,3,0,1] row_mask:0xf bank_mask:0xf bound_ctrl:1\n\t"
      "s_nop 1\n\t"
      "v_add_f32_dpp %[t1], %[t1], %[t1] row_ror:4 row_mask:0xf bank_mask:0xf bound_ctrl:1\n\t"
      "s_nop 1\n\t"
      "v_add_f32_dpp %[t1], %[t1], %[t1] row_ror:8 row_mask:0xf bank_mask:0xf bound_ctrl:1\n\t"
      "v_mov_b32 %[t3], %[t1]\n\t"
      "s_nop 1\n\t"
      "v_permlane16_swap_b32 %[t1], %[t3]\n\t"
      "v_add_f32 %[t1], %[t1], %[t3]\n\t"
      "s_nop 0"
      : [t0] "=&v"(t0), [t1] "=&v"(t1), [t2] "=&v"(t2), [t3] "=&v"(t3)
      : [a0] "v"(a0), [a1] "v"(a1), [a2] "v"(a2), [a3] "v"(a3), [m0] "s"(m0), [m1] "s"(m1));
  return t1;
}

template <int DIR>
DEVI void scan_chain(const Params& p, int b, int h, int blk8, int wave, int lane, int tid, unsigned char* smem) {
  const int rs = lane >> 5, kp = lane & 31;
  const int row = blk8 * 8 + wave * 2 + rs;
  const unsigned char* base = p.ws + OFF_DI;
  float* yacc = (float*)(p.ws + OFF_P + (DIR ? (size_t)C_CG * 2 : 0)) + h * 64 + row;
  constexpr int SG = DIR ? -1 : 1;
#define TG0(chunk) ((chunk) < 8 ? 4096 + b * 64 + (DIR ? 63 - (chunk) * 8 : (chunk) * 8)                     \
                                : b * 2048 + (DIR ? 2047 - ((chunk) * 8 - 64) : ((chunk) * 8 - 64)))
  int C0, C1, C2, C3, C4, S0s, S1s, S2s, S3s, S4s;
#define PIECE(q, C, S)                                                                                       \
  {                                                                                                          \
    const int idx_ = tid + 256 * (q);                                                                        \
    const int g_ = idx_ / 160, r_ = idx_ - g_ * 160;                                                         \
    const bool di_ = r_ < 64;                                                                                \
    S = di_ ? 6144 : 9216;                                                                                   \
    C = (di_ ? h * 1024 + r_ * 16 : (int)SZ_DI + DIR * (int)SZ_DD1 + h * 1536 + (r_ - 64) * 16) + SG * g_ * S; \
  }
  PIECE(0, C0, S0s) PIECE(1, C1, S1s) PIECE(2, C2, S2s) PIECE(3, C3, S3s) PIECE(4, C4, S4s)
#undef PIECE
  const int tv = tid & 63;
  const int CV = (int)(SZ_DI + 2 * SZ_DD1) + (h * 64 + blk8 * 8) * 8 + (tv & 7) * 8 + SG * (tv >> 3) * 3072;
  uint4 st0, st1, st2, st3, st4;
  uint2 stv;
#define ISSUE(chunk)                                                                            \
  {                                                                                             \
    const int tg0_ = TG0(chunk);                                                                \
    st0 = *(const uint4*)(base + (unsigned)(C0 + tg0_ * S0s));                                  \
    st1 = *(const uint4*)(base + (unsigned)(C1 + tg0_ * S1s));                                  \
    st2 = *(const uint4*)(base + (unsigned)(C2 + tg0_ * S2s));                                  \
    st3 = *(const uint4*)(base + (unsigned)(C3 + tg0_ * S3s));                                  \
    st4 = *(const uint4*)(base + (unsigned)(C4 + tg0_ * S4s));                                  \
    stv = *(const uint2*)(base + (unsigned)(CV + tg0_ * 3072));                                 \
  }
#define WRITE(buf)                                                                              \
  {                                                                                             \
    unsigned char* d_ = smem + (buf) * CHUNK_B + tid * 16;                                      \
    *(uint4*)(d_) = st0;                                                                        \
    *(uint4*)(d_ + 4096) = st1;                                                                 \
    *(uint4*)(d_ + 8192) = st2;                                                                 \
    *(uint4*)(d_ + 12288) = st3;                                                                \
    *(uint4*)(d_ + 16384) = st4;                                                                \
    *(uint2*)(smem + (buf) * CHUNK_B + 20480 + tv * 8) = stv;                                   \
  }
  float S0 = 0.f, S1 = 0.f;
  const size_t yoff = (size_t)(lane & 3) * (PROWB / 4);
  float* dump = (float*)(p.ws + OFF_DUMP) + (size_t)(blk8 + 8 * (h + 6 * (2 * b + DIR))) * 256 + (tid & 255);
  float pa0 = 0.f, pa1 = 0.f, pa2 = 0.f, pa3 = 0.f;
  float* yprev = dump;
  ISSUE(0);
  WRITE(0);
  ISSUE(1);
  __syncthreads();
#pragma unroll 1
  for (int chunk = 0; chunk < 264; ++chunk) {
    WRITE((chunk + 1) & 1);
    {
      const int cn = chunk + 2 < 264 ? chunk + 2 : 263;
      ISSUE(cn);
    }
    const unsigned char* B = smem + (chunk & 1) * CHUNK_B;
    const unsigned char* Bl = B + kp * 32;
    const unsigned char* Bd = B + 1024 + kp * 48;
    const unsigned char* Bv = B + 20480 + (wave * 2 + rs) * 8;
    float* ydst = yacc + (size_t)(4 * TG0(chunk)) * (PROWB / 4) + yoff;
    ydst = kp < 4 ? ydst : dump;
    const long ystep = kp < 4 ? (long)SG * 4 * (long)(PROWB / 4) : 0;
    uint4 nd0 = *(const uint4*)(Bl), nd1 = *(const uint4*)(Bl + 16);
    uint4 ne0 = *(const uint4*)(Bd), ne1 = *(const uint4*)(Bd + 16), ne2 = *(const uint4*)(Bd + 32);
    uint2 nv = *(const uint2*)(Bv);
#pragma unroll
    for (int g = 0; g < 8; ++g) {
      const uint4 d0 = nd0, d1 = nd1, e0 = ne0, e1 = ne1, e2 = ne2;
      const uint2 vv = nv;
      if (g < 7) {
        nd0 = *(const uint4*)(Bl + (g + 1) * 2560);
        nd1 = *(const uint4*)(Bl + (g + 1) * 2560 + 16);
        ne0 = *(const uint4*)(Bd + (g + 1) * 2560);
        ne1 = *(const uint4*)(Bd + (g + 1) * 2560 + 16);
        ne2 = *(const uint4*)(Bd + (g + 1) * 2560 + 32);
        nv = *(const uint2*)(Bv + (g + 1) * 64);
      }
      float y0, y1, y2, y3, yv;
      const unsigned long long M0 = 0xAAAAAAAAAAAAAAAAull, M1 = 0xCCCCCCCCCCCCCCCCull;
      if (DIR == 0) {
        scan_pair1<0>(S0, S1, y0, y1, yv, pa0, pa1, pa2, pa3, M0, M1, d0.x, d0.z, d1.x, d1.z, e0.x, e0.z, e1.x, e1.z, e2.x, e2.z, vv.x);
        scan_pair2<0>(S0, S1, y2, y3, yv, d0.y, d0.w, d1.y, d1.w, e0.y, e0.w, e1.y, e1.w, e2.y, e2.w, vv.y);
      } else {
        scan_pair1<1>(S0, S1, y3, y2, yv, pa0, pa1, pa2, pa3, M0, M1, d0.y, d0.w, d1.y, d1.w, e0.y, e0.w, e1.y, e1.w, e2.y, e2.w, vv.y);
        scan_pair2<1>(S0, S1, y1, y0, yv, d0.x, d0.z, d1.x, d1.z, e0.x, e0.z, e1.x, e1.z, e2.x, e2.z, vv.x);
      }
      *yprev = yv;
      yprev = ydst + (long)g * ystep;
      pa0 = y0; pa1 = y1; pa2 = y2; pa3 = y3;
    }
    __syncthreads();
  }
  *yprev = treduce4_asm(pa0, pa1, pa2, pa3, 0xAAAAAAAAAAAAAAAAull, 0xCCCCCCCCCCCCCCCCull);
#undef TG0
#undef ISSUE
#undef WRITE
}

DEVI void attn_task(const Params& p, int l, int task, int lane) {
  const int fr = lane & 15, g = lane >> 4;
  u16* P = (u16*)(p.ws + OFF_P);
  const bool isctx = task >= 2048;
  int b, kvh, qt;
  if (!isctx) { qt = task & 511; kvh = (task >> 9) & 1; b = task >> 10; }
  else { const int t2 = task - 2048; qt = t2 & 15; kvh = (t2 >> 4) & 1; b = t2 >> 5; }
  const int q0 = qt * 16;
  const size_t qrow = isctx ? (size_t)(ML + b * 256 + q0 + fr) : (size_t)(b * 8192 + q0 + fr);
  u16* Pq = P + qrow * PW;
  bf16x8 qf[3][2];
#pragma unroll
  for (int hq = 0; hq < 3; ++hq)
#pragma unroll
    for (int s = 0; s < 2; ++s) qf[hq][s] = *(const bf16x8*)(Pq + C_Q + (kvh * 3 + hq) * 64 + s * 32 + g * 8);
  float mrun[3], lpart[3];
  f32x4 O[3][4];
#pragma unroll
  for (int hq = 0; hq < 3; ++hq) {
    mrun[hq] = p.at_sink[l * 6 + kvh * 3 + hq];
    lpart[hq] = g == 0 ? 1.f : 0.f;
#pragma unroll
    for (int dt = 0; dt < 4; ++dt) O[hq][dt] = f32x4{0.f, 0.f, 0.f, 0.f};
  }
  const int nwin = isctx ? 0 : 9;
  const u16* VT = (const u16*)(p.ws + OFF_VT) + (size_t)((b * 2 + kvh) * 64) * 8192;
  const u16* VTC = (const u16*)(p.ws + OFF_VTC) + (size_t)((b * 2 + kvh) * 64) * 256;

#define ATT_LOAD(it_, KF, VF)                                                                              \
  {                                                                                                        \
    const bool win_ = (it_) < nwin;                                                                        \
    const int kb_ = win_ ? (q0 - 128 + 32 * (it_)) : 32 * ((it_) - nwin);                                  \
    _Pragma("unroll") for (int tt = 0; tt < 2; ++tt) {                                                     \
      const int key = kb_ + 16 * tt + fr;                                                                  \
      size_t krow;                                                                                         \
      if (win_) { const int kc = key < 0 ? 0 : (key > 8191 ? 8191 : key); krow = (size_t)(b * 8192 + kc); } \
      else krow = (size_t)(ML + b * 256 + key);                                                            \
      _Pragma("unroll") for (int s = 0; s < 2; ++s)                                                        \
        KF[tt][s] = *(const bf16x8*)(P + krow * PW + C_KX + kvh * 64 + s * 32 + g * 8);                    \
    }                                                                                                      \
    _Pragma("unroll") for (int dt = 0; dt < 4; ++dt) {                                                     \
      const int d = dt * 16 + fr;                                                                          \
      uint2 lo, hi;                                                                                        \
      if (win_) {                                                                                          \
        int k1 = kb_ + 4 * g, k2 = kb_ + 16 + 4 * g;                                                       \
        if (k1 < 0 || k1 > 8188) k1 = 0;                                                                   \
        if (k2 < 0 || k2 > 8188) k2 = 0;                                                                   \
        lo = *(const uint2*)(VT + (size_t)d * 8192 + k1);                                                  \
        hi = *(const uint2*)(VT + (size_t)d * 8192 + k2);                                                  \
      } else {                                                                                             \
        lo = *(const uint2*)(VTC + d * 256 + kb_ + 4 * g);                                                 \
        hi = *(const uint2*)(VTC + d * 256 + kb_ + 16 + 4 * g);                                            \
      }                                                                                                    \
      uint4 cmb = uint4{lo.x, lo.y, hi.x, hi.y};                                                           \
      VF[dt] = __builtin_bit_cast(bf16x8, cmb);                                                            \
    }                                                                                                      \
  }
  const int nit = nwin + 8;
  bf16x8 nkf[2][2], nvf[4];
  ATT_LOAD(0, nkf, nvf);
#pragma unroll 1
  for (int it = 0; it < nit; ++it) {
    const bool win = it < nwin;
    const int kb = win ? (q0 - 128 + 32 * it) : 32 * (it - nwin);
    bf16x8 kf[2][2], vf[4];
#pragma unroll
    for (int tt = 0; tt < 2; ++tt)
#pragma unroll
      for (int s = 0; s < 2; ++s) kf[tt][s] = nkf[tt][s];
#pragma unroll
    for (int dt = 0; dt < 4; ++dt) vf[dt] = nvf[dt];
    {
      const int itn = it + 1 < nit ? it + 1 : it;
      ATT_LOAD(itn, nkf, nvf);
    }
#pragma unroll
    for (int hq = 0; hq < 3; ++hq) {
      f32x4 sa = f32x4{0.f, 0.f, 0.f, 0.f}, sb = f32x4{0.f, 0.f, 0.f, 0.f};
#pragma unroll
      for (int s = 0; s < 2; ++s) {
        sa = mfma16(kf[0][s], qf[hq][s], sa);
        sb = mfma16(kf[1][s], qf[hq][s], sb);
      }
      float sv[8];
#pragma unroll
      for (int i = 0; i < 4; ++i) {
        sv[i] = sa[i] * 0.125f;
        sv[4 + i] = sb[i] * 0.125f;
      }
      if (win) {
        const int qpos = q0 + fr;
#pragma unroll
        for (int i = 0; i < 8; ++i) {
          const int kpos = kb + 4 * g + (i & 3) + (i >> 2) * 16;
          const int df = qpos - kpos;
          const bool ok = kpos >= 0 && kpos < 8192 && df <= 128 && df >= -128;
          if (!ok) sv[i] = -1e30f;
        }
      }
      float tmax = sv[0];
#pragma unroll
      for (int i = 1; i < 8; ++i) tmax = fmaxf(tmax, sv[i]);
      {
        auto r16 = __builtin_amdgcn_permlane16_swap(__float_as_uint(tmax), __float_as_uint(tmax), false, false);
        tmax = fmaxf(__uint_as_float(r16[0]), __uint_as_float(r16[1]));
        auto r32 = __builtin_amdgcn_permlane32_swap(__float_as_uint(tmax), __float_as_uint(tmax), false, false);
        tmax = fmaxf(__uint_as_float(r32[0]), __uint_as_float(r32[1]));
      }
      const float mnew = fmaxf(mrun[hq], tmax);
      const float alpha = __expf(mrun[hq] - mnew);
      mrun[hq] = mnew;
      float ps = 0.f, pv[8];
#pragma unroll
      for (int i = 0; i < 8; ++i) {
        pv[i] = __expf(sv[i] - mnew);
        ps += pv[i];
      }
      lpart[hq] = lpart[hq] * alpha + ps;
      uint4 pk = uint4{pack2bf(pv[0], pv[1]), pack2bf(pv[2], pv[3]), pack2bf(pv[4], pv[5]), pack2bf(pv[6], pv[7])};
      const bf16x8 pf = __builtin_bit_cast(bf16x8, pk);
#pragma unroll
      for (int dt = 0; dt < 4; ++dt) {
        O[hq][dt] *= alpha;
        O[hq][dt] = mfma16(vf[dt], pf, O[hq][dt]);
      }
    }
  }
#pragma unroll
  for (int hq = 0; hq < 3; ++hq) {
    float lt = lpart[hq] + __shfl_xor(lpart[hq], 16);
    lt += __shfl_xor(lt, 32);
    const float inv = 1.f / lt;
#pragma unroll
    for (int dt = 0; dt < 4; ++dt) {
      u16* dst = Pq + C_GA + (kvh * 3 + hq) * 64 + dt * 16 + 4 * g;
      const uint2 gt = *(const uint2*)dst;
      const float g0 = bf2f((u16)(gt.x & 0xffff)), g1 = bf2f((u16)(gt.x >> 16));
      const float g2 = bf2f((u16)(gt.y & 0xffff)), g3 = bf2f((u16)(gt.y >> 16));
      uint2 o;
      o.x = pack2bf(O[hq][dt][0] * inv * silu_f(g0), O[hq][dt][1] * inv * silu_f(g1));
      o.y = pack2bf(O[hq][dt][2] * inv * silu_f(g2), O[hq][dt][3] * inv * silu_f(g3));
      *(uint2*)dst = o;
    }
  }
}

DEVI void mix_phase(const Params& p, int l, unsigned char* smem) {
  const int tid = TIDX, bid = BIDX;
  const int lane = tid & 63, wave = __builtin_amdgcn_readfirstlane(tid >> 6);
  const int G = (int)gridDim.x;
  const bool iso = (G == 512);
  if (bid < SCAN_BLOCKS) {
    const int xcd = bid & 7, idx = bid >> 3;
    const int chain = xcd * 3 + (idx >> 3), blk8 = idx & 7;
    const int dir = chain & 1, h = (chain >> 1) % 6, b = chain / 12;
    if (dir == 0) scan_chain<0>(p, b, h, blk8, wave, lane, tid, smem);
    else scan_chain<1>(p, b, h, blk8, wave, lane, tid, smem);
  } else {
    unsigned* cnt = (unsigned*)(p.ws + OFF_BAR) + XCD_BAR_WORDS + 64 * l;
    const bool attn_blk = !iso || !(bid >= 256 && bid < 256 + SCAN_BLOCKS);
    int ab, nab;
    if (iso) {
      ab = bid < 256 ? bid - SCAN_BLOCKS : bid - 256 - SCAN_BLOCKS + (256 - SCAN_BLOCKS);
      nab = 2 * (256 - SCAN_BLOCKS);
    } else {
      ab = bid - SCAN_BLOCKS;
      nab = G - SCAN_BLOCKS;
    }
    float* tilef = (float*)smem;
    if (attn_blk) {
      const int aw = ab * 4 + wave, naw = nab * 4;
      const int ntask = 2048 + (l < 3 ? 64 : 0);
      for (int t = aw; t < ntask; t += naw) attn_task(p, l, t, lane);
      convert_weight(p.w_out + (size_t)l * 1024 * 1024, 1024, 1024, (u16*)(p.ws + OFF_WOUTT), tilef, ab, nab);
      asm volatile("s_waitcnt vmcnt(0)" ::: "memory");
      __syncthreads();
      if (tid == 0) {
        __builtin_amdgcn_fence(__ATOMIC_RELEASE, "agent");
        asm volatile("s_waitcnt vmcnt(0)" ::: "memory");
        xb_add(cnt, 1u);
      }
    }
    if (!attn_blk) {
      if (l < 3)
        convert_weight(p.w_in + (size_t)(l + 1) * 1024 * 3840, 1024, 3840, (u16*)(p.ws + OFF_WINT), tilef, bid - 256,
                       SCAN_BLOCKS);
      return;
    }
    if (tid == 0) {
      unsigned sp = 0;
      while (xb_ld(cnt) < (unsigned)nab) {
        __builtin_amdgcn_s_sleep(8);
        if (++sp > (1u << 24)) break;
      }
      __builtin_amdgcn_fence(__ATOMIC_ACQUIRE, "agent");
      asm volatile("s_waitcnt vmcnt(0)" ::: "memory");
    }
    __syncthreads();
    gemm_phase<2>(p, l, smem, ab, nab);
    if (l < 3 && !iso)
      convert_weight(p.w_in + (size_t)(l + 1) * 1024 * 3840, 1024, 3840, (u16*)(p.ws + OFF_WINT), tilef, ab, nab);
  }
}

DEVI void post_phase(const Params& p, int l) {
  const int tid = TIDX;
  const int lane = tid & 63, j = lane >> 4, q = lane & 15;
  const int gw = BIDX * 4 + (tid >> 6), nw = gridDim.x * 4;
  const int ntask = ((l < 3 ? MT : ML) / 4) * 6;
  const float* bonus = (const float*)(p.ws + OFF_BONUS);
  for (int it = gw; it < ntask; it += nw) {
    const int tg = it / 6, h = it - tg * 6;
    const int m = tg * 4 + j;
    unsigned char* rowb = p.ws + OFF_P + (size_t)m * PROWB;
    const float4 yf = *(const float4*)(rowb + (h * 64 + 4 * q) * 4);
    const float4 yb = *(const float4*)(rowb + C_CG * 2 + (h * 64 + 4 * q) * 4);
    const float4 lg = *(const float4*)(p.rw_ln_g + l * 384 + h * 64 + 4 * q);
    const float4 lb = *(const float4*)(p.rw_ln_b + l * 384 + h * 64 + 4 * q);
    const unsigned char* v4 = p.ws + OFF_V4 + ((size_t)(tg * 6 + h) * 64 + 4 * q) * 8 + j * 2;
    const float va = (float)(*(const _Float16*)(v4)), vb = (float)(*(const _Float16*)(v4 + 8));
    const float vc = (float)(*(const _Float16*)(v4 + 16)), vd = (float)(*(const _Float16*)(v4 + 24));
    u16* gp = (u16*)rowb + C_G + h * 64 + 4 * q;
    const uint2 gv = *(const uint2*)gp;
    const float bon = bonus[(size_t)m * 6 + h];
    const float y0 = yf.x + yb.x, y1 = yf.y + yb.y, y2 = yf.z + yb.z, y3 = yf.w + yb.w;
    const float mu = reduce16(y0 + y1 + y2 + y3) * (1.f / 64.f);
    const float d0 = y0 - mu, d1 = y1 - mu, d2 = y2 - mu, d3 = y3 - mu;
    const float var = reduce16(d0 * d0 + d1 * d1 + d2 * d2 + d3 * d3) * (1.f / 64.f);
    const float rstd = rsqrtf(var + 64e-5f);
    const float g0 = bf2f((u16)(gv.x & 0xffff)), g1 = bf2f((u16)(gv.x >> 16));
    const float g2 = bf2f((u16)(gv.y & 0xffff)), g3 = bf2f((u16)(gv.y >> 16));
    uint2 o;
    o.x = pack2bf((d0 * rstd * lg.x + lb.x + bon * va) * silu_f(g0), (d1 * rstd * lg.y + lb.y + bon * vb) * silu_f(g1));
    o.y = pack2bf((d2 * rstd * lg.z + lb.z + bon * vc) * silu_f(g2), (d3 * rstd * lg.w + lb.w + bon * vd) * silu_f(g3));
    *(uint2*)gp = o;
  }
}

DEVI void final_phase(const Params& p) {
  const int tid = TIDX;
  const int lane = tid & 63;
  const int gw = BIDX * 4 + (tid >> 6), nw = gridDim.x * 4;
  for (int m = gw; m < ML; m += nw) {
    float* row = p.out + (size_t)m * 1024;
    float4 v[4];
    float ss = 0.f;
#pragma unroll
    for (int i = 0; i < 4; ++i) {
      v[i] = *(const float4*)(row + i * 256 + lane * 4);
      ss += v[i].x * v[i].x + v[i].y * v[i].y + v[i].z * v[i].z + v[i].w * v[i].w;
    }
    ss = wave_sum(ss);
    const float inv = rsqrtf(ss * (1.f / 1024.f) + 1e-6f);
#pragma unroll
    for (int i = 0; i < 4; ++i) {
      const int c0 = i * 256 + lane * 4;
      const float4 g4 = *(const float4*)(p.final_g + c0);
      float4 o;
      o.x = v[i].x * inv * g4.x; o.y = v[i].y * inv * g4.y; o.z = v[i].z * inv * g4.z; o.w = v[i].w * inv * g4.w;
      *(float4*)(row + c0) = o;
    }
  }
}


#ifndef PROBE_PHASE
#define PROBE_PHASE -1
#endif
#define PB_START() if (PROBE_PHASE >= 0) { pb_t0 = wall_clock64(); }
#define PB_END(id) if (PROBE_PHASE == (id)) { pb_acc += (long long)wall_clock64() - pb_t0; }
__global__ void __launch_bounds__(256, 2) mk_kernel(Params p) {
  __shared__ __attribute__((aligned(16))) unsigned char smem[65536];
  __shared__ uint4 xb_words;
  cg::grid_group grid = cg::this_grid();
  long long pb_t0 = 0, pb_acc = 0;
  unsigned* bar = (unsigned*)(p.ws + OFF_BAR);
  if (threadIdx.x == 0) xb_words = make_uint4(0u, 0u, 0u, 0u);
  __syncthreads();
  if (p.ws == nullptr) grid.sync();
  XcdBarrier xb = xcd_barrier_post(bar, (volatile LAS unsigned*)&xb_words);
  PB_START();
  prologue_phase(p, smem);
  xcd_barrier(xb);
  PB_END(0);
#pragma unroll 1
  for (int l = 0; l < 4; ++l) {
    if (PROBE_PHASE == 8) { PB_START(); xcd_barrier(xb); PB_END(8); }
    PB_START();
    norm_phase(p, l);
    xcd_barrier(xb);
    PB_END(1);
    PB_START();
    gemm_phase<0>(p, l, smem, BIDX, (int)gridDim.x);
    xcd_barrier(xb);
    PB_END(2);
    PB_START();
    prep_phase(p, l, smem);
    xcd_barrier(xb);
    PB_END(3);
    PB_START();
    mix_phase(p, l, smem);
    xcd_barrier(xb);
    PB_END(4);
    PB_START();
    post_phase(p, l);
    xcd_barrier(xb);
    PB_END(5);
    PB_START();
    gemm_phase<1>(p, l, smem, BIDX, (int)gridDim.x);
    xcd_barrier(xb);
    PB_END(6);
  }
  final_phase(p);
  if (PROBE_PHASE >= 0) {
    xcd_barrier(xb);
    if (blockIdx.x == 0) {
      long long k = pb_acc / 20;
      if (k > 60000) k = 60000;
      for (int i = threadIdx.x; i < (int)k; i += 256) p.out[i] += 0.125f;
    }
  }
}

extern "C" void kernel_launch(void* const* d_in, const int* in_sizes, int n_in, void* d_out, int out_size,
                              void* d_ws, size_t ws_size, hipStream_t stream) {
  static int grid_blocks = 0;
  if (!grid_blocks) {
    int dev = 0, cus = 0, per_cu = 0;
    (void)hipGetDevice(&dev);
    (void)hipDeviceGetAttribute(&cus, hipDeviceAttributeMultiprocessorCount, dev);
    (void)hipOccupancyMaxActiveBlocksPerMultiprocessor(&per_cu, mk_kernel, 256, 0);
    if (per_cu > 2) per_cu = 2;
    if (per_cu < 1) per_cu = 1;
    grid_blocks = cus * per_cu;
  }
  Params p{};
  const float** pp = (const float**)&p;
  for (int i = 0; i < 21; ++i) pp[i] = (const float*)d_in[i];
  p.out = (float*)d_out;
  p.ws = (unsigned char*)d_ws;
  (void)hipMemsetAsync((unsigned char*)d_ws + OFF_BAR, 0, (XCD_BAR_WORDS + 256) * 4, stream);
  void* args[] = {&p};
  hipError_t e = hipLaunchCooperativeKernel((void*)mk_kernel, dim3(grid_blocks), dim3(256), args, 0, stream);
  if (e != hipSuccess) fprintf(stderr, "coop launch failed: %s (grid %d)\n", hipGetErrorString(e), grid_blocks);
}
```
